# Optimizing an MI355X kernel written in HIP

```python
import math
import jax, jax.numpy as jnp
from jax import lax
import numpy as np

D_MODEL = 1024
BATCH = 2
SEQ = 16384
DEPTH = 2
DEC_BATCH = 32
DEC_SEQ = 2048
PAST_LEN = 128

PLE_DIM = 256
GRID_W = 64
HEAD_DIM = 64
QBLK = 128
EPS = 1e-6
ROPE_THETA = 10000.0
A_HEADS = 8
A_KV_HEADS = 2
A_GROUPS = A_HEADS // A_KV_HEADS
A_WIDTH = A_HEADS * HEAD_DIM
A_KV_WIDTH = A_KV_HEADS * HEAD_DIM
B_HEADS = 4
B_QK_WIDTH = B_HEADS * 2 * HEAD_DIM
B_V_DIM = 2 * HEAD_DIM
B_WIDTH = B_HEADS * B_V_DIM
AB_SPLITS = (A_WIDTH, A_KV_WIDTH, A_KV_WIDTH, A_WIDTH, B_QK_WIDTH, B_QK_WIDTH, B_WIDTH, B_WIDTH)
AB_OFFSETS = tuple(int(v) for v in np.cumsum(AB_SPLITS)[:-1])
AB_IN = int(sum(AB_SPLITS))
AB_OUT = A_WIDTH + B_WIDTH
ALIBI_SLOPES = tuple(2.0 ** (-8.0 * (h + 1) / B_HEADS) for h in range(B_HEADS))
C_WIDTH = D_MODEL
POOL_WINDOWS = (2, 4, 8, 16)
C_GROUPS = len(POOL_WINDOWS)
C_GRP = C_WIDTH // C_GROUPS
N_EVEN = (DEPTH + 1) // 2
N_ODD = DEPTH // 2

kernel_name = "hybrid_gqa_diffattn_pool_encoder"

F32 = jnp.float32


def rms_norm(x, g):
    xf = x.astype(F32)
    y = xf * lax.rsqrt(jnp.mean(xf * xf, axis=-1, keepdims=True) + EPS) * g.astype(F32)
    return y.astype(x.dtype)


def axial_rope_tables(S):
    rows = S // GRID_W
    row = jnp.repeat(jnp.arange(rows), GRID_W).astype(F32)
    col = jnp.tile(jnp.arange(GRID_W), rows).astype(F32)
    half = HEAD_DIM // 2
    inv = ROPE_THETA ** (-jnp.arange(0, half, 2, dtype=F32) / half)
    ar = row[:, None] * inv
    ac = col[:, None] * inv
    ang = jnp.concatenate([ar, ar, ac, ac], axis=-1)
    return jnp.cos(ang), jnp.sin(ang)


def apply_rope(x, cos, sin):
    x1, x2, x3, x4 = jnp.split(x, 4, axis=-1)
    rot = jnp.concatenate([-x2, x1, -x4, x3], axis=-1)
    return (x.astype(F32) * cos + rot.astype(F32) * sin).astype(x.dtype)


def mixer_ab(xn, cos, sin, w_in, qn_a, kn_a, qn_b, kn_b, lq1, lk1, lq2, lk2, subln_b, w_out, lam_init):
    B, S, _ = xn.shape
    nb = S // QBLK
    proj = xn @ w_in
    qa, ka, va, ga, qb, kb, vb, gb = jnp.split(proj, AB_OFFSETS, axis=-1)
    qa = apply_rope(rms_norm(qa.reshape(B, S, A_KV_HEADS, A_GROUPS, HEAD_DIM), qn_a),
                    cos[:, None, None, :], sin[:, None, None, :])
    ka = apply_rope(rms_norm(ka.reshape(B, S, A_KV_HEADS, HEAD_DIM), kn_a),
                    cos[:, None, :], sin[:, None, :])
    va = va.reshape(B, S, A_KV_HEADS, HEAD_DIM)
    qb = rms_norm(qb.reshape(B, S, B_HEADS, 2, HEAD_DIM), qn_b)
    kb = rms_norm(kb.reshape(B, S, B_HEADS, 2, HEAD_DIM), kn_b)
    vb = vb.reshape(B, S, B_HEADS, B_V_DIM)
    lam = (jnp.exp(jnp.sum(lq1.astype(F32) * lk1.astype(F32)))
           - jnp.exp(jnp.sum(lq2.astype(F32) * lk2.astype(F32))) + lam_init)
    slopes = jnp.asarray(ALIBI_SLOPES, dtype=F32)
    kpos = jnp.arange(S)
    scale = HEAD_DIM ** -0.5

    def block(args):
        qa_blk, qb_blk, bi = args
        s_a = jnp.einsum('bqkgd,bskd->bkgqs', qa_blk, ka).astype(F32) * scale
        p_a = jax.nn.softmax(s_a, axis=-1).astype(va.dtype)
        o_a = jnp.einsum('bkgqs,bskd->bqkgd', p_a, va)
        qpos = bi * QBLK + jnp.arange(QBLK)
        dist = jnp.abs(qpos[:, None] - kpos[None, :]).astype(F32)
        bias = -slopes[:, None, None] * dist
        s_b = jnp.einsum('bqhmd,bshmd->bmhqs', qb_blk, kb).astype(F32) * scale + bias
        p_b = jax.nn.softmax(s_b, axis=-1)
        a_b = (p_b[:, 0] - lam * p_b[:, 1]).astype(vb.dtype)
        o_b = jnp.einsum('bhqs,bshe->bqhe', a_b, vb)
        return o_a, o_b

    def to_blocks(t):
        return jnp.moveaxis(t.reshape((B, nb, QBLK) + t.shape[2:]), 1, 0)

    o_a, o_b = lax.map(block, (to_blocks(qa), to_blocks(qb), jnp.arange(nb)))
    o_a = jnp.moveaxis(o_a, 0, 1).reshape(B, S, A_WIDTH)
    o_b = jnp.moveaxis(o_b, 0, 1).reshape(B, S, B_HEADS, B_V_DIM)
    o_b = (rms_norm(o_b, subln_b) * (1.0 - lam_init)).reshape(B, S, B_WIDTH)
    y = jnp.concatenate([o_a * jax.nn.silu(ga), o_b * jax.nn.silu(gb)], axis=-1)
    return y @ w_out


def mixer_c(xn, w_in, w_grp, c_scale, w_out):
    B, S, _ = xn.shape
    u, g = jnp.split(xn @ w_in, 2, axis=-1)
    ug = u.reshape(B, S, C_GROUPS, C_GRP).astype(F32)
    cs = jnp.concatenate([jnp.zeros_like(ug[:, :1]), jnp.cumsum(ug, axis=1)], axis=1)
    t = jnp.arange(S)
    pooled = []
    for gi, w in enumerate(POOL_WINDOWS):
        lo = jnp.maximum(t - w // 2, 0)
        hi = jnp.minimum(t + w // 2, S)
        cnt = (hi - lo).astype(F32)[None, :, None]
        pooled.append((cs[:, hi, gi] - cs[:, lo, gi]) / cnt - ug[:, :, gi])
    pooled = jnp.stack(pooled, axis=2)
    mixed = jnp.einsum('bsgc,gcd->bsgd', pooled, w_grp.astype(F32)).reshape(B, S, C_WIDTH)
    y = (mixed * c_scale.astype(F32)).astype(xn.dtype) * jax.nn.silu(g)
    return y @ w_out


def trunk(x, p, norm_mix, w_in_ab, qn_a, kn_a, qn_b, kn_b, lam_q1, lam_k1, lam_q2, lam_k2,
          subln_b, w_out_ab, w_in_c, w_grp_c, scale_c, w_out_c, norm_ple, w_ple_gate, w_ple_proj):
    S = x.shape[1]
    cos, sin = axial_rope_tables(S)
    h = x
    for i in range(DEPTH):
        j = i // 2
        xn = rms_norm(h, norm_mix[i])
        if i % 2 == 0:
            lam_init = 0.8 - 0.6 * math.exp(-0.3 * i)
            y = mixer_ab(xn, cos, sin, w_in_ab[j], qn_a[j], kn_a[j], qn_b[j], kn_b[j],
                         lam_q1[j], lam_k1[j], lam_q2[j], lam_k2[j], subln_b[j], w_out_ab[j], lam_init)
        else:
            y = mixer_c(xn, w_in_c[j], w_grp_c[j], scale_c[j], w_out_c[j])
        h = h + y
        gate = jax.nn.sigmoid(rms_norm(h, norm_ple[i]) @ w_ple_gate[i])
        h = h + gate * (p[i] @ w_ple_proj[i])
    return h


def setup_inputs(seed: int = 0) -> dict:
    key = jax.random.key(seed)
    ks = jax.random.split(key, 24)
    nrm = lambda k, shape, s: jax.random.normal(k, shape, F32) * s
    gain = lambda k, shape: 1.0 + 0.05 * jax.random.normal(k, shape, F32)
    return {
        "x_prompt": nrm(ks[0], (BATCH, SEQ, D_MODEL), 1.0),
        "x_sample": nrm(ks[1], (DEC_BATCH, DEC_SEQ, D_MODEL), 1.0),
        "p_prompt": nrm(ks[2], (DEPTH, BATCH, SEQ, PLE_DIM), 1.0),
        "p_sample": nrm(ks[3], (DEPTH, DEC_BATCH, DEC_SEQ, PLE_DIM), 1.0),
        "norm_mix": gain(ks[4], (DEPTH, D_MODEL)),
        "w_in_ab": nrm(ks[5], (N_EVEN, D_MODEL, AB_IN), D_MODEL ** -0.5),
        "qn_a": gain(ks[6], (N_EVEN, HEAD_DIM)),
        "kn_a": gain(ks[7], (N_EVEN, HEAD_DIM)),
        "qn_b": gain(ks[8], (N_EVEN, HEAD_DIM)),
        "kn_b": gain(ks[9], (N_EVEN, HEAD_DIM)),
        "lam_q1": nrm(ks[10], (N_EVEN, HEAD_DIM), 0.1),
        "lam_k1": nrm(ks[11], (N_EVEN, HEAD_DIM), 0.1),
        "lam_q2": nrm(ks[12], (N_EVEN, HEAD_DIM), 0.1),
        "lam_k2": nrm(ks[13], (N_EVEN, HEAD_DIM), 0.1),
        "subln_b": gain(ks[14], (N_EVEN, B_V_DIM)),
        "w_out_ab": nrm(ks[15], (N_EVEN, AB_OUT, D_MODEL), AB_OUT ** -0.5),
        "w_in_c": nrm(ks[16], (N_ODD, D_MODEL, 2 * C_WIDTH), D_MODEL ** -0.5),
        "w_grp_c": nrm(ks[17], (N_ODD, C_GROUPS, C_GRP, C_GRP), C_GRP ** -0.5),
        "scale_c": gain(ks[18], (N_ODD, C_WIDTH)),
        "w_out_c": nrm(ks[19], (N_ODD, C_WIDTH, D_MODEL), C_WIDTH ** -0.5),
        "norm_ple": gain(ks[20], (DEPTH, D_MODEL)),
        "w_ple_gate": nrm(ks[21], (DEPTH, D_MODEL, D_MODEL), D_MODEL ** -0.5),
        "w_ple_proj": nrm(ks[22], (DEPTH, PLE_DIM, D_MODEL), PLE_DIM ** -0.5),
    }


def reference(x_prompt, x_sample, p_prompt, p_sample, norm_mix, w_in_ab, qn_a, kn_a, qn_b, kn_b,
              lam_q1, lam_k1, lam_q2, lam_k2, subln_b, w_out_ab, w_in_c, w_grp_c, scale_c, w_out_c,
              norm_ple, w_ple_gate, w_ple_proj):
    y_prompt = trunk(x_prompt, p_prompt, norm_mix, w_in_ab, qn_a, kn_a, qn_b, kn_b, lam_q1, lam_k1,
                     lam_q2, lam_k2, subln_b, w_out_ab, w_in_c, w_grp_c, scale_c, w_out_c,
                     norm_ple, w_ple_gate, w_ple_proj)
    y_sample = trunk(x_sample, p_sample, norm_mix, w_in_ab, qn_a, kn_a, qn_b, kn_b, lam_q1, lam_k1,
                     lam_q2, lam_k2, subln_b, w_out_ab, w_in_c, w_grp_c, scale_c, w_out_c,
                     norm_ple, w_ple_gate, w_ple_proj)
    return (y_prompt, y_sample)
```

```cpp
#include <hip/hip_runtime.h>
#include <hip/hip_cooperative_groups.h>
#include <cstdio>
#include <cstdint>
namespace cg = cooperative_groups;

#ifndef MK_ONE_LAUNCH
#define MK_ONE_LAUNCH 1
#endif

#define LAS __attribute__((address_space(3)))
typedef unsigned short bf16_t;
typedef short bf16x8 __attribute__((ext_vector_type(8)));
typedef short s16x4 __attribute__((ext_vector_type(4)));
typedef float f32x4 __attribute__((ext_vector_type(4)));
typedef float f32x2 __attribute__((ext_vector_type(2)));
typedef float f32x16 __attribute__((ext_vector_type(16)));
typedef unsigned u32x4 __attribute__((ext_vector_type(4)));
typedef unsigned u32x2 __attribute__((ext_vector_type(2)));
typedef __bf16 bf16x2_t __attribute__((ext_vector_type(2)));

constexpr int DM = 1024;
constexpr int M_PROMPT = 2 * 16384, M_SAMPLE = 32 * 2048, MTOT = M_PROMPT + M_SAMPLE;
constexpr int S_PROMPT = 16384, S_SAMPLE = 2048;
constexpr int PLE = 256;
constexpr int AB_IN = 3328;
constexpr float EPS = 1e-6f;
constexpr float LOG2E = 1.4426950408889634f;
constexpr float QSCALE = 0.125f * LOG2E;

constexpr size_t MiB = 1u << 20;
constexpr size_t UNIT = (size_t)MTOT * DM * 2;
constexpr size_t WS_PROJ = 0;
constexpr size_t WS_XN = 624 * MiB;
constexpr size_t WS_PB0 = 816 * MiB, WS_PB1 = 864 * MiB;
constexpr size_t WS_W = 912 * MiB;
constexpr size_t WS_WIN = WS_W;
constexpr size_t WS_WO = WS_WIN + (size_t)3328 * 1024 * 2;
constexpr size_t WS_WG0 = WS_WO + 2 * MiB, WS_WG1 = WS_WG0 + 2 * MiB;
constexpr size_t WS_WP0 = WS_WG1 + 2 * MiB, WS_WP1 = WS_WP0 + MiB / 2;
constexpr size_t WS_WIC = WS_WP1 + MiB / 2;
constexpr size_t WS_WGRP = WS_WIC + 4 * MiB;
constexpr size_t WS_WOC = WS_WGRP + MiB / 2;
constexpr size_t WS_SS1 = 934 * MiB, WS_SS2 = 940 * MiB, WS_SS3 = 946 * MiB;
constexpr size_t WS_CTL = 952 * MiB;
constexpr size_t WS_BAR = 952 * MiB + 65536;
constexpr size_t WS_END = 953 * MiB;
static_assert(WS_WOC + 2 * MiB <= WS_SS1, "ws map");
constexpr size_t WS_H1B = 0;
constexpr size_t WS_PP = UNIT;
constexpr size_t WS_UG = 0;
constexpr size_t WS_POOL = 2 * UNIT;
constexpr size_t WS_H3B = 2 * UNIT;
constexpr size_t WS_PP1 = 0;
static_assert(3 * UNIT <= WS_XN, "overlay");

__device__ __forceinline__ int fresh_tid() { int t = threadIdx.x; asm volatile("" : "+v"(t)); return t; }
__device__ __forceinline__ unsigned cvtpk(float lo, float hi) { f32x2 v = {lo, hi}; bf16x2_t b = __builtin_convertvector(v, bf16x2_t); return __builtin_bit_cast(unsigned, b); }
__device__ __forceinline__ float bf_lo(unsigned u) { return __uint_as_float(u << 16); }
__device__ __forceinline__ float bf_hi(unsigned u) { return __uint_as_float(u & 0xffff0000u); }
__device__ __forceinline__ float silu_f(float g) { return g * __builtin_amdgcn_rcpf(1.0f + __expf(-g)); }

namespace pg8 {
#define PG8_LAS __attribute__((address_space(3)))
constexpr int BM = 256, BK = 64, HALF = 128, HTB = HALF * BK * 2, STAGE_BYTES = 8 * HTB, NXCD = 8, WGM = 4;

__host__ __device__ __forceinline__ int lds_byte(int r, int c) { const int st = (r >> 4) * 2 + (c >> 5), rr = r & 15, cc = c & 31, ob = rr * 64 + cc * 2; return st * 1024 + (ob ^ (((ob >> 9) & 1) << 5)); }
__host__ __device__ __forceinline__ void stage_rc(int b, int& R, int& C) { const int st = b / 1024, sb = b % 1024, swz = sb ^ (((sb >> 9) & 1) << 5); R = (st >> 1) * 16 + swz / 64; C = (st & 1) * 32 + (swz % 64) / 2; }
__host__ __device__ __forceinline__ int perm32(int rho) { const int n = rho >> 4, i = rho & 15; return 8 * (i >> 2) + 4 * n + (i & 3); }

struct Unit { int pm, pn; };
struct Gemm { const bf16_t* A; const bf16_t* Bt; int lda, ldb, K, a_koff_pn; int M, N; };

struct StaticOrder {
    int nM, nN, nwg, G, c;
    __host__ __device__ void init(int M, int N, int G_, int c_) { nM = M / BM; nN = N / BM; nwg = nM * nN; G = G_; c = c_; }
    __host__ __device__ __forceinline__ bool next(int i, Unit& u) const {
        const long L = (long)i * G + c; if (L >= nwg) return false;
        int wgid = (int)L; { const int q = nwg / NXCD, r = nwg % NXCD, xcd = wgid % NXCD, off = wgid / NXCD; wgid = (xcd < r ? xcd * (q + 1) : r * (q + 1) + (xcd - r) * q) + off; }
        const int nig = WGM * nN, gid = wgid / nig, fm = gid * WGM, gsz = (nM - fm) < WGM ? (nM - fm) : WGM;
        u.pm = fm + ((wgid % nig) % gsz); u.pn = (wgid % nig) / gsz; return true;
    }
};

__device__ __forceinline__ float row_rstd16(const float* ss, int row, int fq) {
    const f32x4 a = *(const f32x4*)(ss + (size_t)row * 16 + 4 * fq);
    float s = (a[0] + a[1]) + (a[2] + a[3]);
    s += __shfl_xor(s, 16); s += __shfl_xor(s, 32);
    return __builtin_amdgcn_rsqf(s * (1.0f / 1024.0f) + EPS);
}

struct EpiBf16S {
    static constexpr bool PERM = true;
    bf16_t* O; int ldc; const float* ss;
    __device__ __forceinline__ void operator()(const f32x4 (&acc)[2][2][4][2], const Unit& u, int wr, int wc, int fr, int fq) const {
        const int row0 = u.pm * BM + wr * 64 + fr, col0 = u.pn * BM + wc * 32 + 8 * fq;
#pragma unroll
        for (int ai = 0; ai < 2; ++ai)
#pragma unroll
            for (int m = 0; m < 4; ++m) {
                const int row = row0 + ai * HALF + m * 16;
                const float sc = ss ? row_rstd16(ss, row, fq) : 1.0f;
                bf16_t* rowp = O + (size_t)row * ldc + col0;
#pragma unroll
                for (int bj = 0; bj < 2; ++bj) { const f32x4 v0 = acc[ai][bj][m][0] * sc, v1 = acc[ai][bj][m][1] * sc;
                    u32x4 w; w.x = cvtpk(v0[0], v0[1]); w.y = cvtpk(v0[2], v0[3]); w.z = cvtpk(v1[0], v1[1]); w.w = cvtpk(v1[2], v1[3]);
                    *(u32x4*)(rowp + bj * HALF) = w; }
            }
    }
};
struct EpiProj {
    static constexpr bool PERM = true;
    bf16_t* O; const float* wtab;
    __device__ __forceinline__ void operator()(const f32x4 (&acc)[2][2][4][2], const Unit& u, int wr, int wc, int fr, int fq) const {
        const int row0 = u.pm * BM + wr * 64 + fr;
        const bool ktile = (u.pn <= 2) || (u.pn >= 5 && u.pn <= 8);
        if (!ktile) {
            const int col0 = u.pn * BM + wc * 32 + 8 * fq;
#pragma unroll
            for (int ai = 0; ai < 2; ++ai)
#pragma unroll
                for (int m = 0; m < 4; ++m) { bf16_t* rowp = O + (size_t)(row0 + ai * HALF + m * 16) * AB_IN + col0;
#pragma unroll
                    for (int bj = 0; bj < 2; ++bj) { const f32x4 v0 = acc[ai][bj][m][0], v1 = acc[ai][bj][m][1];
                        u32x4 w; w.x = cvtpk(v0[0], v0[1]); w.y = cvtpk(v0[2], v0[3]); w.z = cvtpk(v1[0], v1[1]); w.w = cvtpk(v1[2], v1[3]); *(u32x4*)(rowp + bj * HALF) = w; } }
            return;
        }
        const bool norm = (u.pn != 2) || (wc < 2), rope = (u.pn < 2) || ((u.pn == 2) && (wc < 2));
        const float* wp = wtab + 64 * ((u.pn >= 2) + (u.pn >= 5) + (u.pn >= 7));
        const float qs = (u.pn < 2 || u.pn == 5 || u.pn == 6) ? QSCALE : 1.0f;
        const float sgn = (fq & 2) ? 1.0f : -1.0f;
        f32x4 wv[2][2];
#pragma unroll
        for (int bj = 0; bj < 2; ++bj) { wv[bj][0] = *(const f32x4*)(wp + 32 * bj + 8 * fq); wv[bj][1] = *(const f32x4*)(wp + 32 * bj + 8 * fq + 4); }
        const int colb = u.pn * BM + 64 * wc + 8 * fq;
#pragma unroll
        for (int ai = 0; ai < 2; ++ai)
#pragma unroll
            for (int m = 0; m < 4; ++m) {
                int row = row0 + ai * HALF + m * 16; asm volatile("" : "+v"(row));
                float v[2][8]; float ss = 0.f;
#pragma unroll
                for (int bj = 0; bj < 2; ++bj)
#pragma unroll
                    for (int k = 0; k < 8; ++k) { v[bj][k] = acc[ai][bj][m][k >> 2][k & 3]; ss += v[bj][k] * v[bj][k]; }
                if (norm) {
                    ss += __shfl_xor(ss, 16); ss += __shfl_xor(ss, 32);
                    const float rstd = __builtin_amdgcn_rsqf(ss * (1.0f / 64.0f) + EPS);
#pragma unroll
                    for (int bj = 0; bj < 2; ++bj) { const f32x4 w0 = wv[bj][0], w1 = wv[bj][1];
#pragma unroll
                        for (int k = 0; k < 4; ++k) { v[bj][k] *= rstd * w0[k]; v[bj][4 + k] *= rstd * w1[k]; } }
                }
                if (rope) {
                    const int t = (row < M_PROMPT) ? (row & (S_PROMPT - 1)) : ((row - M_PROMPT) & (S_SAMPLE - 1));
                    const float prow = (float)(t >> 6), pcol = (float)(t & 63);
#pragma unroll
                    for (int k = 0; k < 8; ++k) {
                        const float inv = exp2f(-(float)(8 * (fq & 1) + k) * (13.287712379549449f / 16.0f));
                        const float ar = prow * inv, ac = pcol * inv;
                        const float p0 = __shfl_xor(v[0][k], 32), p1 = __shfl_xor(v[1][k], 32);
                        v[0][k] = v[0][k] * __cosf(ar) + sgn * p0 * __sinf(ar);
                        v[1][k] = v[1][k] * __cosf(ac) + sgn * p1 * __sinf(ac);
                    }
                }
#pragma unroll
                for (int bj = 0; bj < 2; ++bj) { u32x4 w; w.x = cvtpk(v[bj][0] * qs, v[bj][1] * qs); w.y = cvtpk(v[bj][2] * qs, v[bj][3] * qs); w.z = cvtpk(v[bj][4] * qs, v[bj][5] * qs); w.w = cvtpk(v[bj][6] * qs, v[bj][7] * qs);
                    *(u32x4*)(O + (size_t)row * AB_IN + colb + 32 * bj) = w; }
                asm volatile("" ::: "memory");
            }
    }
};
struct EpiF32 {
    static constexpr bool PERM = false;
    bf16_t* O;
    __device__ __forceinline__ void operator()(const f32x4 (&acc)[2][2][4][2], const Unit& u, int wr, int wc, int fr, int fq) const {
        const int row0 = u.pm * BM + wr * 64 + fr, col0 = u.pn * BM + wc * 32 + 4 * fq;
#pragma unroll
        for (int ai = 0; ai < 2; ++ai)
#pragma unroll
            for (int m = 0; m < 4; ++m) { bf16_t* rowp = O + (size_t)(row0 + ai * HALF + m * 16) * DM + col0;
#pragma unroll
                for (int bj = 0; bj < 2; ++bj)
#pragma unroll
                    for (int n = 0; n < 2; ++n) { const f32x4 v = acc[ai][bj][m][n]; u32x2 w; w.x = cvtpk(v[0], v[1]); w.y = cvtpk(v[2], v[3]); *(u32x2*)(rowp + bj * HALF + n * 16) = w; } }
    }
};
template <bool BF16BASE> struct EpiResid {
    static constexpr bool PERM = true;
    const float* baseA; const float* baseB; int split; const bf16_t* baseH; bf16_t* hb; float* ss;
    __device__ __forceinline__ void operator()(const f32x4 (&acc)[2][2][4][2], const Unit& u, int wr, int wc, int fr, int fq) const {
        const int row0 = u.pm * BM + wr * 64 + fr, col0 = u.pn * BM + wc * 32 + 8 * fq;
        float sqv[8];
#pragma unroll
        for (int ai = 0; ai < 2; ++ai)
#pragma unroll
            for (int m = 0; m < 4; ++m) {
                const int row = row0 + ai * HALF + m * 16;
                const size_t off = (size_t)row * DM + col0; float sq = 0.f;
                const float* bp = BF16BASE ? nullptr : ((row < split ? baseA + (size_t)row * DM : baseB + (size_t)(row - split) * DM) + col0);
#pragma unroll
                for (int bj = 0; bj < 2; ++bj) { f32x4 b0, b1;
                    if (BF16BASE) { const u32x4 r = *(const u32x4*)(baseH + off + bj * HALF); b0 = (f32x4){bf_lo(r.x), bf_hi(r.x), bf_lo(r.y), bf_hi(r.y)}; b1 = (f32x4){bf_lo(r.z), bf_hi(r.z), bf_lo(r.w), bf_hi(r.w)}; }
                    else { b0 = *(const f32x4*)(bp + bj * HALF); b1 = *(const f32x4*)(bp + bj * HALF + 4); }
                    const f32x4 v0 = acc[ai][bj][m][0] + b0, v1 = acc[ai][bj][m][1] + b1;
                    u32x4 w; w.x = cvtpk(v0[0], v0[1]); w.y = cvtpk(v0[2], v0[3]); w.z = cvtpk(v1[0], v1[1]); w.w = cvtpk(v1[2], v1[3]); *(u32x4*)(hb + off + bj * HALF) = w;
                    sq += ((v0[0] * v0[0] + v0[1] * v0[1]) + (v0[2] * v0[2] + v0[3] * v0[3])) + ((v1[0] * v1[0] + v1[1] * v1[1]) + (v1[2] * v1[2] + v1[3] * v1[3])); }
                sq += __shfl_xor(sq, 16); sq += __shfl_xor(sq, 32);
                sqv[ai * 4 + m] = sq;
                if (m & 1) asm volatile("" ::: "memory");
            }
#pragma unroll
        for (int h = 0; h < 2; ++h) { const float val = (fq == 0) ? sqv[4 * h] : (fq == 1) ? sqv[4 * h + 1] : (fq == 2) ? sqv[4 * h + 2] : sqv[4 * h + 3];
            ss[(size_t)(row0 + h * HALF + fq * 16) * 16 + u.pn * 4 + wc] = val; }
    }
};
struct EpiGate {
    static constexpr bool PERM = true;
    const bf16_t* hin; const bf16_t* pp; const float* ssin; bf16_t* hb; float* ssout; float* outf;
    __device__ __forceinline__ void operator()(const f32x4 (&acc)[2][2][4][2], const Unit& u, int wr, int wc, int fr, int fq) const {
        const int row0 = u.pm * BM + wr * 64 + fr, col0 = u.pn * BM + wc * 32 + 8 * fq;
        float sqv[8];
#pragma unroll
        for (int ai = 0; ai < 2; ++ai)
#pragma unroll
            for (int m = 0; m < 4; ++m) {
                int row = row0 + ai * HALF + m * 16; asm volatile("" : "+v"(row));
                const float rstd = row_rstd16(ssin, row, fq);
                const size_t off = (size_t)row * DM + col0; float sq = 0.f;
#pragma unroll
                for (int bj = 0; bj < 2; ++bj) { const size_t o2 = off + bj * HALF;
                    const u32x4 hr = *(const u32x4*)(hin + o2), pr = *(const u32x4*)(pp + o2);
                    const float h[8] = {bf_lo(hr.x), bf_hi(hr.x), bf_lo(hr.y), bf_hi(hr.y), bf_lo(hr.z), bf_hi(hr.z), bf_lo(hr.w), bf_hi(hr.w)};
                    const float p[8] = {bf_lo(pr.x), bf_hi(pr.x), bf_lo(pr.y), bf_hi(pr.y), bf_lo(pr.z), bf_hi(pr.z), bf_lo(pr.w), bf_hi(pr.w)};
                    float v[8];
#pragma unroll
                    for (int i = 0; i < 8; ++i) { const float a = acc[ai][bj][m][i >> 2][i & 3] * rstd; v[i] = h[i] + p[i] * __builtin_amdgcn_rcpf(1.0f + __expf(-a)); sq += v[i] * v[i]; }
                    if (outf) { __builtin_nontemporal_store((f32x4){v[0], v[1], v[2], v[3]}, (f32x4*)(outf + o2)); __builtin_nontemporal_store((f32x4){v[4], v[5], v[6], v[7]}, (f32x4*)(outf + o2 + 4)); }
                    if (hb) { u32x4 w; w.x = cvtpk(v[0], v[1]); w.y = cvtpk(v[2], v[3]); w.z = cvtpk(v[4], v[5]); w.w = cvtpk(v[6], v[7]); *(u32x4*)(hb + o2) = w; } }
                sq += __shfl_xor(sq, 16); sq += __shfl_xor(sq, 32);
                sqv[ai * 4 + m] = sq;
                if (m & 1) asm volatile("" ::: "memory");
            }
        if (ssout) {
#pragma unroll
            for (int h = 0; h < 2; ++h) { const float val = (fq == 0) ? sqv[4 * h] : (fq == 1) ? sqv[4 * h + 1] : (fq == 2) ? sqv[4 * h + 2] : sqv[4 * h + 3];
                ssout[(size_t)(row0 + h * HALF + fq * 16) * 16 + u.pn * 4 + wc] = val; }
        }
    }
};
struct EpiGrp {
    static constexpr bool PERM = true;
    bf16_t* Z; const bf16_t* ug; const float* cs;
    __device__ __forceinline__ void operator()(const f32x4 (&acc)[2][2][4][2], const Unit& u, int wr, int wc, int fr, int fq) const {
        const int row0 = u.pm * BM + wr * 64 + fr, col0 = u.pn * BM + wc * 32 + 8 * fq;
        f32x4 csv[2][2];
#pragma unroll
        for (int bj = 0; bj < 2; ++bj) { csv[bj][0] = *(const f32x4*)(cs + col0 + bj * HALF); csv[bj][1] = *(const f32x4*)(cs + col0 + bj * HALF + 4); }
#pragma unroll
        for (int ai = 0; ai < 2; ++ai)
#pragma unroll
            for (int m = 0; m < 4; ++m) {
                const int row = row0 + ai * HALF + m * 16;
#pragma unroll
                for (int bj = 0; bj < 2; ++bj) { const int col = col0 + bj * HALF;
                    const u32x4 g8 = *(const u32x4*)(ug + (size_t)row * 2048 + 1024 + col);
                    const f32x4 c0 = csv[bj][0], c1 = csv[bj][1];
                    const f32x4 v0 = acc[ai][bj][m][0] * c0, v1 = acc[ai][bj][m][1] * c1;
                    u32x4 w;
                    w.x = cvtpk(v0[0] * silu_f(bf_lo(g8.x)), v0[1] * silu_f(bf_hi(g8.x)));
                    w.y = cvtpk(v0[2] * silu_f(bf_lo(g8.y)), v0[3] * silu_f(bf_hi(g8.y)));
                    w.z = cvtpk(v1[0] * silu_f(bf_lo(g8.z)), v1[1] * silu_f(bf_hi(g8.z)));
                    w.w = cvtpk(v1[2] * silu_f(bf_lo(g8.w)), v1[3] * silu_f(bf_hi(g8.w)));
                    *(u32x4*)(Z + (size_t)row * DM + col) = w; }
                asm volatile("" ::: "memory");
            }
    }
};

template <class Epi, bool ALIGN_EPI = true>
__device__ __forceinline__ void gemm_phase(PG8_LAS unsigned char* lds, const Gemm g, const StaticOrder& S, const Epi& E) {
    const int tid = fresh_tid(), wid = __builtin_amdgcn_readfirstlane(tid >> 6), lane = tid & 63, wr = wid >> 2, wc = wid & 3, fr = lane & 15, fq = lane >> 4;
    const int K = g.K, nt = K / BK;
    unsigned voffA[2], voffB[2];
#pragma unroll
    for (int i = 0; i < 2; ++i) { int R, C; stage_rc(tid * 16 + i * 8192, R, C); const int Rb = Epi::PERM ? ((R & ~31) + perm32(R & 31)) : R;
        voffA[i] = (unsigned)(R * g.lda + C) * 2u; voffB[i] = (unsigned)(Rb * g.ldb + C) * 2u; }
    const size_t kstep = (size_t)(BK * 2);
    const size_t hstepA = (size_t)HALF * g.lda * 2, hstepB = (size_t)HALF * g.ldb * 2;
    const size_t tstepA = 2 * hstepA, tstepB = 2 * hstepB;
    const unsigned ldsw = (unsigned)wid * 1024u;
    const int aoff = lds_byte(wr * 64 + fr, fq * 8), boff = lds_byte(wc * 32 + fr, fq * 8);
#define PG8_SA(b, h) (((b) * 2 + (h)) * HTB)
#define PG8_SB(b, h) ((4 + (b) * 2 + (h)) * HTB)
#define PG8_STAGE(bufoff, gbase, voff) do { _Pragma("unroll") for (int _i = 0; _i < 2; ++_i) \
        __builtin_amdgcn_global_load_lds((const unsigned*)((const char*)(gbase) + (voff)[_i]), (PG8_LAS unsigned*)(lds + (bufoff) + ldsw + _i * 8192), 16, 0, 0); } while (0)
#define PG8_LDA(dst, b, h) do { _Pragma("unroll") for (int m = 0; m < 4; ++m) _Pragma("unroll") for (int k = 0; k < 2; ++k) dst[m][k] = *(const PG8_LAS bf16x8*)(lds + PG8_SA(b, h) + aoff + m * 2048 + k * 1024); } while (0)
#define PG8_LDB(dst, b, h) do { _Pragma("unroll") for (int n = 0; n < 2; ++n) _Pragma("unroll") for (int k = 0; k < 2; ++k) dst[n][k] = *(const PG8_LAS bf16x8*)(lds + PG8_SB(b, h) + boff + n * 2048 + k * 1024); } while (0)
#define PG8_MMA(ai, bj, At, Bt) do { __builtin_amdgcn_s_setprio(1); _Pragma("unroll") for (int m = 0; m < 4; ++m) _Pragma("unroll") for (int n = 0; n < 2; ++n) _Pragma("unroll") for (int k = 0; k < 2; ++k) \
        acc[ai][bj][m][n] = __builtin_amdgcn_mfma_f32_16x16x32_bf16(Bt[n][k], At[m][k], acc[ai][bj][m][n], 0, 0, 0); __builtin_amdgcn_s_setprio(0); } while (0)
#define PG8_WAIT_V(n) asm volatile("s_waitcnt vmcnt(" #n ")" ::: "memory")
#define PG8_WAIT_L(n) asm volatile("s_waitcnt lgkmcnt(" #n ")" ::: "memory")
#define PG8_BAR __builtin_amdgcn_s_barrier()
#define PG8_SCHED __builtin_amdgcn_sched_barrier(0)
    Unit cur, nxt; int ui = 0;
    if (!S.next(0, cur)) return;
    f32x4 acc[2][2][4][2];
#pragma unroll
    for (int a = 0; a < 2; ++a)
#pragma unroll
        for (int b = 0; b < 2; ++b)
#pragma unroll
            for (int m = 0; m < 4; ++m)
#pragma unroll
                for (int n = 0; n < 2; ++n) acc[a][b][m][n] = (f32x4){0.f, 0.f, 0.f, 0.f};
    bf16x8 At[4][2], B0[2][2], B1[2][2];
    const char* cA = (const char*)g.A + (size_t)cur.pm * tstepA + (size_t)cur.pn * g.a_koff_pn * 2; const char* cB = (const char*)g.Bt + (size_t)cur.pn * tstepB;
    PG8_STAGE(PG8_SB(0, 0), cB, voffB); PG8_STAGE(PG8_SB(0, 1), cB + hstepB, voffB); PG8_STAGE(PG8_SA(0, 0), cA, voffA); PG8_STAGE(PG8_SA(0, 1), cA + hstepA, voffA);
    if (wr == 1) PG8_BAR;
    PG8_WAIT_V(2); PG8_BAR;
    PG8_STAGE(PG8_SB(1, 0), cB + kstep, voffB); PG8_STAGE(PG8_SA(1, 0), cA + kstep, voffA); PG8_STAGE(PG8_SB(1, 1), cB + hstepB + kstep, voffB);
    PG8_WAIT_V(6); PG8_BAR;
    for (;;) {
        const bool has_next = S.next(ui + 1, nxt);
        const char* nA = has_next ? (const char*)g.A + (size_t)nxt.pm * tstepA + (size_t)nxt.pn * g.a_koff_pn * 2 : cA; const char* nB = has_next ? (const char*)g.Bt + (size_t)nxt.pn * tstepB : cB;
        for (int t = 0; t < nt; t += 2) {
            const bool last = (t == nt - 2);
            const char* a1 = cA + (size_t)(t + 1) * kstep;
            const char* a2 = last ? nA : cA + (size_t)(t + 2) * kstep; const char* b2 = last ? nB : cB + (size_t)(t + 2) * kstep;
            const char* a3 = a2 + kstep; const char* b3 = b2 + kstep;
            PG8_LDB(B0, 0, 0); PG8_LDB(B1, 0, 1); PG8_SCHED; PG8_LDA(At, 0, 0); PG8_STAGE(PG8_SA(1, 1), a1 + hstepA, voffA);
            PG8_WAIT_V(8); PG8_WAIT_L(0); PG8_BAR; PG8_MMA(0, 0, At, B0); PG8_MMA(0, 1, At, B1); PG8_BAR; PG8_SCHED;
            PG8_LDA(At, 0, 1); PG8_STAGE(PG8_SB(0, 0), b2, voffB); PG8_STAGE(PG8_SB(0, 1), b2 + hstepB, voffB); PG8_STAGE(PG8_SA(0, 0), a2, voffA);
            PG8_WAIT_V(8); PG8_WAIT_L(0); PG8_BAR; PG8_MMA(1, 0, At, B0); PG8_MMA(1, 1, At, B1); PG8_BAR; PG8_SCHED;
            PG8_LDB(B0, 1, 0); PG8_LDB(B1, 1, 1); PG8_SCHED; PG8_LDA(At, 1, 0); PG8_STAGE(PG8_SA(0, 1), a2 + hstepA, voffA);
            PG8_WAIT_V(8); PG8_WAIT_L(0); PG8_BAR; PG8_MMA(0, 0, At, B0); PG8_MMA(0, 1, At, B1); PG8_BAR; PG8_SCHED;
            PG8_LDA(At, 1, 1); PG8_STAGE(PG8_SB(1, 0), b3, voffB); PG8_STAGE(PG8_SB(1, 1), b3 + hstepB, voffB); PG8_STAGE(PG8_SA(1, 0), a3, voffA);
            PG8_WAIT_V(8); PG8_WAIT_L(0); PG8_BAR; PG8_MMA(1, 0, At, B0); PG8_MMA(1, 1, At, B1); PG8_BAR; PG8_SCHED;
        }
        if constexpr (ALIGN_EPI) { if (wr == 0) PG8_BAR; }
        E(acc, cur, wr, wc, fr, fq);
        if (!has_next) break;
#pragma unroll
        for (int a = 0; a < 2; ++a)
#pragma unroll
            for (int b = 0; b < 2; ++b)
#pragma unroll
                for (int m = 0; m < 4; ++m)
#pragma unroll
                    for (int n = 0; n < 2; ++n) acc[a][b][m][n] = (f32x4){0.f, 0.f, 0.f, 0.f};
        cur = nxt; cA = nA; cB = nB; ++ui;
        if constexpr (ALIGN_EPI) { if (wr == 1) PG8_BAR; }
    }
    PG8_WAIT_V(0);
    if constexpr (!ALIGN_EPI) { if (wr == 0) PG8_BAR; }
    PG8_BAR;
#undef PG8_SA
#undef PG8_SB
#undef PG8_STAGE
#undef PG8_LDA
#undef PG8_LDB
#undef PG8_MMA
#undef PG8_WAIT_V
#undef PG8_WAIT_L
#undef PG8_BAR
#undef PG8_SCHED
}
}

namespace att {
typedef short v4i16_t __attribute__((ext_vector_type(4)));
constexpr int KP = 144;
constexpr int VPA = 192, VPB = 320;
constexpr int BUFA = 64 * KP + 64 * VPA;
constexpr int BUFB = 2 * 64 * KP + 64 * VPB;
constexpr int CP = 132;
constexpr int CTL_OFF = 131072;
constexpr float THR = 8.0f;
static_assert(128 * CP * 4 <= 3 * BUFB && 3 * BUFB <= CTL_OFF && 6 * BUFA <= CTL_OFF, "LDS map");

__device__ __forceinline__ s16x4 vtr(const LAS unsigned char* p) { return __builtin_bit_cast(s16x4, __builtin_amdgcn_ds_read_tr16_b64_v4i16((LAS v4i16_t*)p)); }
__device__ __forceinline__ float pair_max(float v) { auto rr = __builtin_amdgcn_permlane32_swap(__float_as_uint(v), __float_as_uint(v), false, false); return fmaxf(__uint_as_float(rr[0]), __uint_as_float(rr[1])); }
__device__ __forceinline__ float pair_sum(float v) { auto rr = __builtin_amdgcn_permlane32_swap(__float_as_uint(v), __float_as_uint(v), false, false); return __uint_as_float(rr[0]) + __uint_as_float(rr[1]); }
__device__ __forceinline__ float max3f(float a, float b, float c) { float r; asm("v_max3_f32 %0, %1, %2, %3" : "=v"(r) : "v"(a), "v"(b), "v"(c)); return r; }
__device__ __forceinline__ bf16x8 pack8(const f32x16& p, int b) {
    u32x4 w; w.x = cvtpk(p[b], p[b + 1]); w.y = cvtpk(p[b + 2], p[b + 3]); w.z = cvtpk(p[b + 4], p[b + 5]); w.w = cvtpk(p[b + 6], p[b + 7]);
    return __builtin_bit_cast(bf16x8, w);
}
#define VFRAG(lo, hi) (bf16x8){lo[0], lo[1], lo[2], lo[3], hi[0], hi[1], hi[2], hi[3]}


__device__ __forceinline__ void q_prep(bf16x8 (&qr)[4], const bf16_t* Qg, const float* w, int hi, bool rope, int tpos) {
    float x[4][8]; float ss = 0.f;
#pragma unroll
    for (int d0 = 0; d0 < 4; ++d0) { const u32x4 raw = *(const u32x4*)(Qg + d0 * 16 + hi * 8);
        x[d0][0] = bf_lo(raw.x); x[d0][1] = bf_hi(raw.x); x[d0][2] = bf_lo(raw.y); x[d0][3] = bf_hi(raw.y); x[d0][4] = bf_lo(raw.z); x[d0][5] = bf_hi(raw.z); x[d0][6] = bf_lo(raw.w); x[d0][7] = bf_hi(raw.w);
#pragma unroll
        for (int j = 0; j < 8; ++j) ss += x[d0][j] * x[d0][j]; }
    ss = pair_sum(ss);
    const float rstd = __builtin_amdgcn_rsqf(ss * (1.0f / 64.0f) + EPS);
#pragma unroll
    for (int d0 = 0; d0 < 4; ++d0) { const f32x4 w0 = *(const f32x4*)(w + d0 * 16 + hi * 8), w1 = *(const f32x4*)(w + d0 * 16 + hi * 8 + 4);
#pragma unroll
        for (int j = 0; j < 4; ++j) { x[d0][j] *= rstd * w0[j]; x[d0][4 + j] *= rstd * w1[j]; } }
    if (rope) {
        const float prow = (float)(tpos >> 6), pcol = (float)(tpos & 63);
#pragma unroll
        for (int j = 0; j < 8; ++j) {
            const float inv = exp2f(-(float)(8 * hi + j) * (13.287712379549449f / 16.0f));
            const float ar = prow * inv, ac = pcol * inv;
            const float cr = __cosf(ar), sr = __sinf(ar), cc = __cosf(ac), sc_ = __sinf(ac);
            const float y0 = x[0][j], y1 = x[1][j], y2 = x[2][j], y3 = x[3][j];
            x[0][j] = y0 * cr - y1 * sr; x[1][j] = y1 * cr + y0 * sr; x[2][j] = y2 * cc - y3 * sc_; x[3][j] = y3 * cc + y2 * sc_;
        }
    }
#pragma unroll
    for (int d0 = 0; d0 < 4; ++d0) { u32x4 wv; wv.x = cvtpk(x[d0][0] * QSCALE, x[d0][1] * QSCALE); wv.y = cvtpk(x[d0][2] * QSCALE, x[d0][3] * QSCALE); wv.z = cvtpk(x[d0][4] * QSCALE, x[d0][5] * QSCALE); wv.w = cvtpk(x[d0][6] * QSCALE, x[d0][7] * QSCALE);
        qr[d0] = __builtin_bit_cast(bf16x8, wv); }
}

__device__ __forceinline__ void qk_tile(f32x16& p0, f32x16& p1, const LAS unsigned char* kb, const bf16x8 (&qr)[4]) {
#pragma unroll
    for (int d0 = 0; d0 < 4; ++d0) {
        const bf16x8 k0 = *(const LAS bf16x8*)(kb + d0 * 32), k1 = *(const LAS bf16x8*)(kb + 32 * KP + d0 * 32);
        p0 = __builtin_amdgcn_mfma_f32_32x32x16_bf16(k0, qr[d0], p0, 0, 0, 0);
        p1 = __builtin_amdgcn_mfma_f32_32x32x16_bf16(k1, qr[d0], p1, 0, 0, 0);
    }
}
__device__ __forceinline__ void qk_tile_c(f32x16& p0, f32x16& p1, const f32x16& negm, const LAS unsigned char* kb, const bf16x8 (&qr)[4]) {
#pragma unroll
    for (int d0 = 0; d0 < 4; ++d0) {
        const bf16x8 k0 = *(const LAS bf16x8*)(kb + d0 * 32), k1 = *(const LAS bf16x8*)(kb + 32 * KP + d0 * 32);
        if (d0 == 0) { p0 = __builtin_amdgcn_mfma_f32_32x32x16_bf16(k0, qr[0], negm, 0, 0, 0); p1 = __builtin_amdgcn_mfma_f32_32x32x16_bf16(k1, qr[0], negm, 0, 0, 0); }
        else { p0 = __builtin_amdgcn_mfma_f32_32x32x16_bf16(k0, qr[d0], p0, 0, 0, 0); p1 = __builtin_amdgcn_mfma_f32_32x32x16_bf16(k1, qr[d0], p1, 0, 0, 0); }
    }
}
__device__ __forceinline__ void softmax_head(f32x16& p0, f32x16& p1, float mref, float& m_run, float& l_run, float& alpha, bool& resc) {
    float ma = max3f(p0[0], p0[1], p1[0]), mb = max3f(p0[2], p0[3], p1[1]); ma = max3f(ma, p1[2], p1[3]);
#pragma unroll
    for (int r = 4; r < 16; r += 4) { ma = max3f(ma, p0[r], p0[r + 1]); mb = max3f(mb, p0[r + 2], p0[r + 3]); ma = max3f(ma, p1[r], p1[r + 1]); mb = max3f(mb, p1[r + 2], p1[r + 3]); }
    float mx = pair_max(fmaxf(ma, mb));
    float shift = m_run - mref;
    const float ex = mx - shift;
    resc = __builtin_amdgcn_ballot_w64(ex > THR) != 0ull;
    alpha = 1.0f;
    if (resc) { const float dl = fmaxf(ex, 0.f); alpha = __builtin_amdgcn_exp2f(-dl); l_run *= alpha; m_run += dl; shift += dl; }
    if (__builtin_amdgcn_ballot_w64(shift != 0.f) != 0ull) {
#pragma unroll
        for (int r = 0; r < 16; ++r) { p0[r] -= shift; p1[r] -= shift; }
    }
}
#define ATT_BAR() asm volatile("s_waitcnt lgkmcnt(0)\n\ts_barrier" ::: "memory")
#define ATT_SCHED(NMFMA, NV) do { __builtin_amdgcn_sched_group_barrier(0x100, 12, 0); __builtin_amdgcn_sched_group_barrier(0x002, 12, 0); _Pragma("unroll") for (int _g = 0; _g < (NMFMA); ++_g) { \
    __builtin_amdgcn_sched_group_barrier(0x100, 2, 0); __builtin_amdgcn_sched_group_barrier(0x008, 1, 0); __builtin_amdgcn_sched_group_barrier(0x002, (NV), 0); } } while (0)

__device__ __forceinline__ void attn_a_unit(LAS unsigned char* lds, const bf16_t* proj, bf16_t* O, long seq_row0, int S, int head, int qblk, float mfix, const float* qnw) {
    const int tid = fresh_tid(), lane = tid & 63, r32 = lane & 31, hi = lane >> 5; const int wid = __builtin_amdgcn_readfirstlane(tid >> 6);
    const int kvh = head >> 2;
    const long qrow = seq_row0 + qblk * 256 + wid * 32 + r32;
    const bf16_t* Qg = proj + qrow * AB_IN + head * 64;
    const int srow = tid >> 3, sch = tid & 7;
    const bf16_t* kld = proj + (seq_row0 + srow) * AB_IN + 512 + kvh * 64 + sch * 8;
    const bf16_t* vld = kld + 128;
    const unsigned kst = srow * KP + sch * 16, vst = 64 * KP + srow * VPA + sch * 16;
    constexpr int SUP = 2 * BUFA;
    const int NS = S / 128;
    u32x4 kr0, vr0, kr1, vr1;
#define A_LOAD(T) do { const size_t go = (size_t)(T) * 128 * AB_IN; kr0 = *(const u32x4*)(kld + go); vr0 = *(const u32x4*)(vld + go); kr1 = *(const u32x4*)(kld + go + (size_t)64 * AB_IN); vr1 = *(const u32x4*)(vld + go + (size_t)64 * AB_IN); } while (0)
#define A_STORE(off) do { *(LAS u32x4*)(lds + (off) + kst) = kr0; *(LAS u32x4*)(lds + (off) + vst) = vr0; *(LAS u32x4*)(lds + (off) + BUFA + kst) = kr1; *(LAS u32x4*)(lds + (off) + BUFA + vst) = vr1; } while (0)
    A_LOAD(0);
    bf16x8 qr[4];
#pragma unroll
    for (int d0 = 0; d0 < 4; ++d0) qr[d0] = *(const bf16x8*)(Qg + d0 * 16 + hi * 8);
    A_STORE(0);
    A_LOAD(1); A_STORE(SUP);
    ATT_BAR();
    f32x16 o0 = {}, o1 = {}; float l_run = 0.f;
    const unsigned kfo = r32 * KP + hi * 16;
    const unsigned vfo = 64 * KP + (4 * hi + ((lane & 15) >> 2)) * VPA + (16 * ((lane >> 4) & 1) + 4 * (lane & 3)) * 2;
    f32x16 sc0, sc1, negm;
#pragma unroll
    for (int r = 0; r < 16; ++r) negm[r] = -mfix;
    asm volatile("" : "+v"(negm));
    qk_tile_c(sc0, sc1, negm, lds + kfo, qr);
    int sV = 0, sK = SUP, sW = 2 * SUP;
    for (int T = 0; T < NS; ++T) {
        A_LOAD(min(T + 2, NS - 1));
#pragma unroll
        for (int sub = 0; sub < 2; ++sub) {
            f32x16 sn0, sn1;
            qk_tile_c(sn0, sn1, negm, lds + (sub == 0 ? sV + BUFA : sK) + kfo, qr);
            float ls = 0.f;
#pragma unroll
            for (int r = 0; r < 16; ++r) { sc0[r] = __builtin_amdgcn_exp2f(sc0[r]); ls += sc0[r]; }
#pragma unroll
            for (int r = 0; r < 16; ++r) { sc1[r] = __builtin_amdgcn_exp2f(sc1[r]); ls += sc1[r]; }
            l_run += ls;
#pragma unroll
            for (int ks = 0; ks < 4; ++ks) {
                const bf16x8 pa = (ks < 2) ? pack8(sc0, 8 * ks) : pack8(sc1, 8 * (ks - 2));
                const LAS unsigned char* vb = lds + sV + sub * BUFA + vfo + ks * 16 * VPA;
                const s16x4 l0 = vtr(vb), h0 = vtr(vb + 8 * VPA), l1 = vtr(vb + 64), h1 = vtr(vb + 8 * VPA + 64);
                o0 = __builtin_amdgcn_mfma_f32_32x32x16_bf16(VFRAG(l0, h0), pa, o0, 0, 0, 0);
                o1 = __builtin_amdgcn_mfma_f32_32x32x16_bf16(VFRAG(l1, h1), pa, o1, 0, 0, 0);
            }
            ATT_SCHED(16, 5);
            if (sub == 1) { A_STORE(sW); ATT_BAR(); }
            else asm volatile("" ::: "memory");
            sc0 = sn0; sc1 = sn1;
        }
        { const int tmp = sV; sV = sK; sK = sW; sW = tmp; }
    }
#undef A_LOAD
#undef A_STORE
    const float inv = 1.0f / pair_sum(l_run);
    constexpr int SP = 272;
    LAS unsigned char* stg = lds + wid * (32 * SP);
#pragma unroll
    for (int db = 0; db < 2; ++db)
#pragma unroll
        for (int g4 = 0; g4 < 4; ++g4) { const f32x16& o = db ? o1 : o0; const int d = 32 * db + 8 * g4 + 4 * hi;
            *(LAS f32x4*)(stg + r32 * SP + d * 4) = (f32x4){o[4 * g4] * inv, o[4 * g4 + 1] * inv, o[4 * g4 + 2] * inv, o[4 * g4 + 3] * inv}; }
    asm volatile("s_waitcnt lgkmcnt(0)" ::: "memory");
    const long wrow0 = seq_row0 + qblk * 256 + wid * 32;
#pragma unroll
    for (int i = 0; i < 4; ++i) {
        const int row = i * 8 + (lane >> 3), ch = lane & 7;
        const f32x4 a = *(const LAS f32x4*)(stg + row * SP + ch * 32), b = *(const LAS f32x4*)(stg + row * SP + ch * 32 + 16);
        const u32x4 gg = *(const u32x4*)(proj + (wrow0 + row) * AB_IN + 768 + head * 64 + ch * 8);
        u32x4 w;
        w.x = cvtpk(a[0] * silu_f(bf_lo(gg.x)), a[1] * silu_f(bf_hi(gg.x))); w.y = cvtpk(a[2] * silu_f(bf_lo(gg.y)), a[3] * silu_f(bf_hi(gg.y)));
        w.z = cvtpk(b[0] * silu_f(bf_lo(gg.z)), b[1] * silu_f(bf_hi(gg.z))); w.w = cvtpk(b[2] * silu_f(bf_lo(gg.w)), b[3] * silu_f(bf_hi(gg.w)));
        *(u32x4*)(O + (wrow0 + row) * DM + head * 64 + ch * 8) = w;
    }
    ATT_BAR();
}

__device__ __forceinline__ void bias_init(f32x16& p0, f32x16& p1, int qloc, int qw0, int kv0, int hi, float nsl, float base) {
    const float fq = (float)(qloc - kv0 - 4 * hi);
    if (kv0 + 63 < qw0 || kv0 > qw0 + 31) {
        const float k = (kv0 + 63 < qw0) ? nsl : -nsl; const float b = k * fq + base;
#pragma unroll
        for (int r = 0; r < 16; ++r) { const float c = (float)((r & 3) + 8 * (r >> 2)); p0[r] = fmaf(-c, k, b); p1[r] = fmaf(-(c + 32.0f), k, b); }
    } else {
#pragma unroll
        for (int r = 0; r < 16; ++r) { const float c = (float)((r & 3) + 8 * (r >> 2)); p0[r] = fmaf(nsl, fabsf(fq - c), base); p1[r] = fmaf(nsl, fabsf(fq - (c + 32.0f)), base); }
    }
}

__device__ __forceinline__ void attn_b_unit(LAS unsigned char* lds, const bf16_t* proj, bf16_t* O, long seq_row0, int S, int hb, int qblk, float lam, const float* subln, float slope2, int t_lo, int t_hi, float mfix, const float* qnw) {
    const int tid = fresh_tid(), lane = tid & 63, r32 = lane & 31, hi = lane >> 5; const int wid = __builtin_amdgcn_readfirstlane(tid >> 6);
    const int map = wid >> 2, wq = wid & 3;
    const int qw0 = qblk * 128 + wq * 32, qloc = qw0 + r32;
    const long qrow = seq_row0 + qloc;
    const bf16_t* Qg = proj + qrow * AB_IN + 1280 + (hb * 2 + map) * 64;

    const int srow = tid >> 3, sch = tid & 7;
    const bf16_t* k1ld = proj + (seq_row0 + srow) * AB_IN + 1792 + hb * 128 + sch * 8;
    const bf16_t* k2ld = k1ld + 64;
    const int vrow0 = tid >> 4, vch = tid & 15;
    const bf16_t* vld = proj + (seq_row0 + vrow0) * AB_IN + 2304 + hb * 128 + vch * 8;
    const unsigned k1st = srow * KP + sch * 16, k2st = 64 * KP + k1st, vst = 2 * 64 * KP + vrow0 * VPB + vch * 16;
    u32x4 k1r, k2r, v0r, v1r;
#define B_LOAD(tt) do { const size_t go = (size_t)(tt) * 64 * AB_IN; k1r = *(const u32x4*)(k1ld + go); k2r = *(const u32x4*)(k2ld + go); v0r = *(const u32x4*)(vld + go); v1r = *(const u32x4*)(vld + go + (size_t)32 * AB_IN); } while (0)
#define B_STORE(off) do { *(LAS u32x4*)(lds + (off) + k1st) = k1r; *(LAS u32x4*)(lds + (off) + k2st) = k2r; *(LAS u32x4*)(lds + (off) + vst) = v0r; *(LAS u32x4*)(lds + (off) + vst + 32 * VPB) = v1r; } while (0)
    B_LOAD(t_lo);
    bf16x8 qr[4];
#pragma unroll
    for (int d0 = 0; d0 < 4; ++d0) qr[d0] = *(const bf16x8*)(Qg + d0 * 16 + hi * 8);
    B_STORE(0);
    B_LOAD(t_lo + 1); B_STORE(BUFB);
    ATT_BAR();
    f32x16 o[4] = {{}, {}, {}, {}}; float l_run = 0.f;
    const unsigned kfo = map * 64 * KP + r32 * KP + hi * 16;
    const unsigned vfo = 2 * 64 * KP + (4 * hi + ((lane & 15) >> 2)) * VPB + (16 * ((lane >> 4) & 1) + 4 * (lane & 3)) * 2;
    const float nsl = -slope2;
    f32x16 sc0, sc1;
    bias_init(sc0, sc1, qloc, qw0, t_lo * 64, hi, nsl, -mfix);
    qk_tile(sc0, sc1, lds + kfo, qr);
    int sV = 0, sK = BUFB, sW = 2 * BUFB;
    for (int t = t_lo; t < t_hi; ++t) {
        B_LOAD(min(t + 2, t_hi - 1));
        f32x16 sn0, sn1;
        bias_init(sn0, sn1, qloc, qw0, (t + 1) * 64, hi, nsl, -mfix);
        qk_tile(sn0, sn1, lds + sK + kfo, qr);
        float ls = 0.f;
#pragma unroll
        for (int r = 0; r < 16; ++r) { sc0[r] = __builtin_amdgcn_exp2f(sc0[r]); ls += sc0[r]; }
#pragma unroll
        for (int r = 0; r < 16; ++r) { sc1[r] = __builtin_amdgcn_exp2f(sc1[r]); ls += sc1[r]; }
        l_run += ls;
#pragma unroll
        for (int ks = 0; ks < 4; ++ks) {
            const bf16x8 pa = (ks < 2) ? pack8(sc0, 8 * ks) : pack8(sc1, 8 * (ks - 2));
            const LAS unsigned char* vb = lds + sV + vfo + ks * 16 * VPB;
#pragma unroll
            for (int db = 0; db < 4; ++db) {
                const s16x4 l0 = vtr(vb + db * 64), h0 = vtr(vb + 8 * VPB + db * 64);
                o[db] = __builtin_amdgcn_mfma_f32_32x32x16_bf16(VFRAG(l0, h0), pa, o[db], 0, 0, 0);
            }
        }
        ATT_SCHED(24, 5);
        B_STORE(sW);
        ATT_BAR();
        sc0 = sn0; sc1 = sn1;
        { const int tmp = sV; sV = sK; sK = sW; sW = tmp; }
    }
#undef B_LOAD
#undef B_STORE
    const float inv = 1.0f / pair_sum(l_run);
    LAS float* comb = (LAS float*)lds + (wq * 32 + r32) * CP;
    if (map == 1) {
#pragma unroll
        for (int db = 0; db < 4; ++db)
#pragma unroll
            for (int g4 = 0; g4 < 4; ++g4) { const int d = 32 * db + 8 * g4 + 4 * hi;
                *(LAS f32x4*)(comb + d) = (f32x4){o[db][4 * g4] * inv, o[db][4 * g4 + 1] * inv, o[db][4 * g4 + 2] * inv, o[db][4 * g4 + 3] * inv}; }
    }
    ATT_BAR();
    if (map == 0) {
        float ss = 0.f;
#pragma unroll
        for (int db = 0; db < 4; ++db)
#pragma unroll
            for (int g4 = 0; g4 < 4; ++g4) { const int d = 32 * db + 8 * g4 + 4 * hi; const f32x4 c = *(const LAS f32x4*)(comb + d);
#pragma unroll
                for (int i = 0; i < 4; ++i) { const float a = o[db][4 * g4 + i] * inv - lam * c[i]; o[db][4 * g4 + i] = a; ss += a * a; } }
        ss = pair_sum(ss);
        const float rstd = __builtin_amdgcn_rsqf(ss * (1.0f / 128.0f) + EPS) * 0.8f;
#pragma unroll
        for (int db = 0; db < 4; ++db)
#pragma unroll
            for (int g4 = 0; g4 < 4; ++g4) { const int d = 32 * db + 8 * g4 + 4 * hi;
                *(LAS f32x4*)(comb + d) = (f32x4){o[db][4 * g4] * rstd, o[db][4 * g4 + 1] * rstd, o[db][4 * g4 + 2] * rstd, o[db][4 * g4 + 3] * rstd}; }
        asm volatile("s_waitcnt lgkmcnt(0)" ::: "memory");
        const long wrow0 = seq_row0 + qblk * 128 + wq * 32;
        const LAS float* wst = (const LAS float*)lds + (wq * 32) * CP;
#pragma unroll
        for (int i = 0; i < 8; ++i) {
            const int row = i * 4 + (lane >> 4), ch = lane & 15;
            const f32x4 a = *(const LAS f32x4*)(wst + row * CP + ch * 8), b = *(const LAS f32x4*)(wst + row * CP + ch * 8 + 4);
            const u32x4 gg = *(const u32x4*)(proj + (wrow0 + row) * AB_IN + 2816 + hb * 128 + ch * 8);
            const f32x4 s0 = *(const f32x4*)(subln + ch * 8), s1 = *(const f32x4*)(subln + ch * 8 + 4);
            u32x4 w;
            w.x = cvtpk(a[0] * s0[0] * silu_f(bf_lo(gg.x)), a[1] * s0[1] * silu_f(bf_hi(gg.x))); w.y = cvtpk(a[2] * s0[2] * silu_f(bf_lo(gg.y)), a[3] * s0[3] * silu_f(bf_hi(gg.y)));
            w.z = cvtpk(b[0] * s1[0] * silu_f(bf_lo(gg.z)), b[1] * s1[1] * silu_f(bf_hi(gg.z))); w.w = cvtpk(b[2] * s1[2] * silu_f(bf_lo(gg.w)), b[3] * s1[3] * silu_f(bf_hi(gg.w)));
            *(u32x4*)(O + (wrow0 + row) * DM + 512 + hb * 128 + ch * 8) = w;
        }
    }
    ATT_BAR();
}
}

__device__ __forceinline__ float wave_sum(float v) {
#pragma unroll
    for (int o = 1; o < 64; o <<= 1) v += __shfl_xor(v, o);
    return v;
}
__device__ __forceinline__ void p0_transpose_item(const float* W, int K, int N, const float* gain, bf16_t* WT, int row_off, LAS float* scr, int item, int lane, bool kperm = false) {
    const int nblk = N / 32, kb = item / nblk, nb = item % nblk, k0 = 64 * kb, n0 = 32 * nb;
    int n0d = n0;
    if (kperm) { const int pn = n0 >> 8, c = n0 & 255; if (pn <= 2 || (pn >= 5 && pn <= 8)) n0d = (n0 & ~255) + 128 * ((c >> 5) & 1) + 32 * (c >> 6); }
#pragma unroll 8
    for (int i = 0; i < 32; ++i) { const int kk = 2 * i + (lane >> 5); float v = W[(size_t)(k0 + kk) * N + n0 + (lane & 31)]; if (gain) v *= gain[k0 + kk]; scr[kk * 33 + (lane & 31)] = v; }
    asm volatile("s_waitcnt lgkmcnt(0)" ::: "memory");
    const int c = lane & 7;
#pragma unroll
    for (int j = 0; j < 4; ++j) { const int n = (lane >> 3) + 8 * j; const LAS float* s = scr + (8 * c) * 33 + n;
        u32x4 o; o.x = cvtpk(s[0 * 33], s[1 * 33]); o.y = cvtpk(s[2 * 33], s[3 * 33]); o.z = cvtpk(s[4 * 33], s[5 * 33]); o.w = cvtpk(s[6 * 33], s[7 * 33]);
        *(u32x4*)(WT + (size_t)(row_off + n0d + n) * K + k0 + 8 * c) = o; }
    asm volatile("s_waitcnt lgkmcnt(0)" ::: "memory");
}


template <int W2, int R> __device__ __forceinline__ void pool_run(const bf16_t* ug, bf16_t* pool, int sb, int S, int t0, int col) {
    constexpr int NR = R + 2 * W2;
    u32x4 r[NR];
#pragma unroll
    for (int i = 0; i < NR; ++i) { const int t = t0 - W2 + i; const bool ok = (t >= 0) && (t < S); const int tc = ok ? t : t0;
        const u32x4 v = *(const u32x4*)(ug + (size_t)(sb + tc) * 2048 + col); r[i] = ok ? v : (u32x4){0u, 0u, 0u, 0u}; }
    float s[8];
#pragma unroll
    for (int c = 0; c < 8; ++c) s[c] = 0.f;
#pragma unroll
    for (int i = 0; i < 2 * W2; ++i) { s[0] += bf_lo(r[i].x); s[1] += bf_hi(r[i].x); s[2] += bf_lo(r[i].y); s[3] += bf_hi(r[i].y); s[4] += bf_lo(r[i].z); s[5] += bf_hi(r[i].z); s[6] += bf_lo(r[i].w); s[7] += bf_hi(r[i].w); }
#pragma unroll
    for (int k = 0; k < R; ++k) {
        const int t = t0 + k; const int cnt = min(t + W2, S) - max(t - W2, 0); const float ic = 1.0f / (float)cnt;
        const u32x4 c = r[k + W2];
        u32x4 w;
        w.x = cvtpk(s[0] * ic - bf_lo(c.x), s[1] * ic - bf_hi(c.x)); w.y = cvtpk(s[2] * ic - bf_lo(c.y), s[3] * ic - bf_hi(c.y));
        w.z = cvtpk(s[4] * ic - bf_lo(c.z), s[5] * ic - bf_hi(c.z)); w.w = cvtpk(s[6] * ic - bf_lo(c.w), s[7] * ic - bf_hi(c.w));
        *(u32x4*)(pool + (size_t)(sb + t) * DM + col) = w;
        if (k < R - 1) { const u32x4 a = r[k + 2 * W2], b = r[k];
            s[0] += bf_lo(a.x) - bf_lo(b.x); s[1] += bf_hi(a.x) - bf_hi(b.x); s[2] += bf_lo(a.y) - bf_lo(b.y); s[3] += bf_hi(a.y) - bf_hi(b.y);
            s[4] += bf_lo(a.z) - bf_lo(b.z); s[5] += bf_hi(a.z) - bf_hi(b.z); s[6] += bf_lo(a.w) - bf_lo(b.w); s[7] += bf_hi(a.w) - bf_hi(b.w); }
    }
}


#define XB_TMO      128
#define XB_XCNT(j)  (256  + 64 * (j))
#define XB_XSUB(j)  (1280 + 64 * (j))
#define XB_XGEN(j)  (2304 + 64 * (j))
#define XB_TOP      3328
#define XB_TOPGEN   3392
#define XCD_BAR_WORDS 3456
#define XB_SPIN_CAP (1u << 18)
__device__ __forceinline__ unsigned xb_ld(unsigned* p)              { return __hip_atomic_load(p, __ATOMIC_RELAXED, __HIP_MEMORY_SCOPE_AGENT); }
__device__ __forceinline__ unsigned xb_add(unsigned* p, unsigned v) { return __hip_atomic_fetch_add(p, v, __ATOMIC_RELAXED, __HIP_MEMORY_SCOPE_AGENT); }
__device__ __forceinline__ unsigned xb_xcc_id() { return (unsigned)__builtin_amdgcn_s_getreg((3 << 11) | 20) & 0xFu; }
#define XB_SPIN(cond, bar) do { unsigned _sp = 0; while (cond) { __builtin_amdgcn_s_sleep(1); \
    if ((++_sp & 255u) == 0u) { if (xb_ld(&(bar)[XB_TMO])) break; if (_sp > XB_SPIN_CAP) { atomicAdd(&(bar)[XB_TMO], 1u); break; } } } } while (0)
struct XcdBarrier { unsigned* bar; unsigned x; volatile LAS unsigned* st; };
__device__ __forceinline__ XcdBarrier xcd_barrier_post(unsigned* bar, volatile LAS unsigned* st) {
    XcdBarrier b; b.bar = bar; b.x = xb_xcc_id(); b.st = st;
    if (threadIdx.x == 0) (void)xb_add(&bar[XB_XCNT(b.x)], 1u);
    return b;
}
__device__ __forceinline__ void xcd_barrier_complete(unsigned* bar, unsigned x, unsigned& nloc, unsigned& nx) {
    const unsigned G = gridDim.x * gridDim.y * gridDim.z;
    unsigned sum, cnt, mine, sp = 0u;
    for (;;) {
        sum = 0u; cnt = 0u; mine = 0u;
#pragma unroll
        for (unsigned j = 0; j < 16; ++j) { const unsigned c = xb_ld(&bar[XB_XCNT(j)]); sum += c; cnt += (c > 0u) ? 1u : 0u; mine = (j == x) ? c : mine; }
        if (sum == G) break;
        __builtin_amdgcn_s_sleep(1);
        if ((++sp & 255u) == 0u) { if (xb_ld(&bar[XB_TMO])) break; if (sp > XB_SPIN_CAP) { atomicAdd(&bar[XB_TMO], 1u); break; } }
    }
    nloc = mine > 0u ? mine : 1u; nx = cnt > 0u ? cnt : 1u;
}
__device__ __forceinline__ void xcd_barrier(const XcdBarrier& b) {
    asm volatile("s_waitcnt vmcnt(0)" ::: "memory");
    __syncthreads();
    if (threadIdx.x == 0) {
        unsigned* bar = b.bar;
        __builtin_amdgcn_s_waitcnt(0);
        unsigned nloc = b.st[0], nx = b.st[1];
        if (nloc == 0u) { xcd_barrier_complete(bar, b.x, nloc, nx); b.st[0] = nloc; b.st[1] = nx; }
        const unsigned old = xb_add(&bar[XB_XSUB(b.x)], 1u);
        const unsigned gen = old / nloc;
        if (old + 1u == (gen + 1u) * nloc) {
            __builtin_amdgcn_fence(__ATOMIC_RELEASE, "agent");
            asm volatile("s_waitcnt vmcnt(0)" ::: "memory");
            const unsigned og = xb_add(&bar[XB_TOP], 1u);
            const unsigned tg = og / nx;
            if (og + 1u == (tg + 1u) * nx) xb_add(&bar[XB_TOPGEN], 1u);
            else XB_SPIN(xb_ld(&bar[XB_TOPGEN]) == tg, bar);
            __builtin_amdgcn_fence(__ATOMIC_ACQUIRE, "agent");
            xb_add(&bar[XB_XGEN(b.x)], 1u);
            asm volatile("s_waitcnt vmcnt(0)" ::: "memory");
        } else {
            XB_SPIN(xb_ld(&bar[XB_XGEN(b.x)]) == gen, bar);
            __builtin_amdgcn_fence(__ATOMIC_ACQUIRE, "agent");
            asm volatile("s_waitcnt vmcnt(0)" ::: "memory");
        }
    }
    __syncthreads();
}

struct Args { const float* in[23]; float* out; unsigned char* ws; int ph_lo, ph_hi; };

__global__ void __launch_bounds__(512, 2) mega_fwd(Args args) {
    extern __shared__ __attribute__((aligned(16))) unsigned char lds_raw[];
    LAS unsigned char* lds = (LAS unsigned char*)lds_raw;
    const int G = gridDim.x, bx = blockIdx.x;
#define FRESH_IDS const int tid = fresh_tid(), lane = tid & 63; const int wave = __builtin_amdgcn_readfirstlane(tid >> 6); (void)lane; (void)wave
    unsigned char* ws = args.ws;
    const int lo = args.ph_lo, hi = args.ph_hi;
#define IN(k) (lo <= (k) && (k) < hi)
#define SEAM(k) do { if (IN(k) && IN((k) + 1)) { xcd_barrier(xbar); } } while (0)
    volatile LAS unsigned* xst = (volatile LAS unsigned*)(lds + att::CTL_OFF + 64);
    if (threadIdx.x < 2) xst[threadIdx.x] = 0u;
    __syncthreads();
    XcdBarrier xbar; xbar.bar = (unsigned*)(ws + WS_BAR); xbar.x = 0; xbar.st = xst;
    if (lo > 0) xbar = xcd_barrier_post((unsigned*)(ws + WS_BAR), xst);
    const float* x_prompt = args.in[0]; const float* x_sample = args.in[1];
    bf16_t* proj = (bf16_t*)(ws + WS_PROJ); bf16_t* XN = (bf16_t*)(ws + WS_XN);
    float* outp = args.out;

    if (IN(0)) {
        FRESH_IDS;
        LAS float* scr = (LAS float*)(lds + wave * 16384);
        const int gw = bx * 8 + wave, NGW = G * 8;
        constexpr int I0 = 16 * 104, I1 = 512, I2 = 512, I3 = 512, I4 = 128, I5 = 128, I6 = 1024, I7 = 128, I8 = 512;
        constexpr int NITEMS = I0 + I1 + I2 + I3 + I4 + I5 + I6 + I7 + I8;
        for (int it = gw; it < NITEMS; it += NGW) {
            int r = it;
            if (r < I0) { p0_transpose_item(args.in[5], 1024, 3328, nullptr, (bf16_t*)(ws + WS_WIN), 0, scr, r, lane, true); continue; } r -= I0;
            if (r < I1) { p0_transpose_item(args.in[15], 1024, 1024, nullptr, (bf16_t*)(ws + WS_WO), 0, scr, r, lane); continue; } r -= I1;
            if (r < I2) { p0_transpose_item(args.in[21], 1024, 1024, args.in[20], (bf16_t*)(ws + WS_WG0), 0, scr, r, lane); continue; } r -= I2;
            if (r < I3) { p0_transpose_item(args.in[21] + 1024 * 1024, 1024, 1024, args.in[20] + 1024, (bf16_t*)(ws + WS_WG1), 0, scr, r, lane); continue; } r -= I3;
            if (r < I4) { p0_transpose_item(args.in[22], 256, 1024, nullptr, (bf16_t*)(ws + WS_WP0), 0, scr, r, lane); continue; } r -= I4;
            if (r < I5) { p0_transpose_item(args.in[22] + 256 * 1024, 256, 1024, nullptr, (bf16_t*)(ws + WS_WP1), 0, scr, r, lane); continue; } r -= I5;
            if (r < I6) { p0_transpose_item(args.in[16], 1024, 2048, args.in[4] + 1024, (bf16_t*)(ws + WS_WIC), 0, scr, r, lane); continue; } r -= I6;
            if (r < I7) { const int gi = r / 32; p0_transpose_item(args.in[17] + (size_t)gi * 65536, 256, 256, nullptr, (bf16_t*)(ws + WS_WGRP), gi * 256, scr, r % 32, lane); continue; } r -= I7;
            p0_transpose_item(args.in[19], 1024, 1024, nullptr, (bf16_t*)(ws + WS_WOC), 0, scr, r, lane);
        }
        if (bx == 0) { if (tid < 256) ((float*)(ws + WS_CTL + 4096))[tid] = args.in[6 + (tid >> 6)][tid & 63];
                       if (tid == 0) *(unsigned*)(ws + WS_CTL) = 0u; for (int i = tid; i < XCD_BAR_WORDS; i += 512) ((unsigned*)(ws + WS_BAR))[i] = 0u; }
        const float* g0 = args.in[4];
        for (int m0 = gw * 2; m0 < MTOT; m0 += NGW * 2) {
            f32x4 v[2][4];
#pragma unroll
            for (int tk = 0; tk < 2; ++tk) { const int m = m0 + tk; const float* xr = (m < M_PROMPT) ? x_prompt + (size_t)m * DM : x_sample + (size_t)(m - M_PROMPT) * DM;
#pragma unroll
                for (int j = 0; j < 4; ++j) v[tk][j] = __builtin_nontemporal_load((const f32x4*)xr + lane + 64 * j); }
#pragma unroll
            for (int tk = 0; tk < 2; ++tk) { float s2 = 0.f;
#pragma unroll
                for (int j = 0; j < 4; ++j) s2 += (v[tk][j][0] * v[tk][j][0] + v[tk][j][1] * v[tk][j][1]) + (v[tk][j][2] * v[tk][j][2] + v[tk][j][3] * v[tk][j][3]);
                const float rstd = __builtin_amdgcn_rsqf(wave_sum(s2) * (1.0f / DM) + EPS);
                u32x2* o8 = (u32x2*)(XN + (size_t)(m0 + tk) * DM) + lane;
#pragma unroll
                for (int j = 0; j < 4; ++j) { const f32x4 gg = ((const f32x4*)g0)[lane + 64 * j]; u32x2 w;
                    w.x = cvtpk(v[tk][j][0] * rstd * gg[0], v[tk][j][1] * rstd * gg[1]); w.y = cvtpk(v[tk][j][2] * rstd * gg[2], v[tk][j][3] * rstd * gg[3]); o8[64 * j] = w; } }
        }
        const size_t gt = (size_t)bx * 512 + tid, NT = (size_t)G * 512;
#pragma unroll 1
        for (int l = 0; l < 2; ++l) {
            const float* pp = args.in[2] + (size_t)l * M_PROMPT * PLE; const float* ps = args.in[3] + (size_t)l * M_SAMPLE * PLE;
            bf16_t* pb = (bf16_t*)(ws + (l ? WS_PB1 : WS_PB0));
            constexpr size_t NP8 = (size_t)M_PROMPT * PLE / 8, NA8 = (size_t)MTOT * PLE / 8;
            for (size_t i0 = gt; i0 < NA8; i0 += 4 * NT) {
                f32x4 a[4], b[4];
#pragma unroll
                for (int q = 0; q < 4; ++q) { const size_t i = i0 + (size_t)q * NT; if (i < NA8) { const float* src = (i < NP8) ? pp + i * 8 : ps + (i - NP8) * 8; a[q] = __builtin_nontemporal_load((const f32x4*)src); b[q] = __builtin_nontemporal_load((const f32x4*)src + 1); } }
#pragma unroll
                for (int q = 0; q < 4; ++q) { const size_t i = i0 + (size_t)q * NT; if (i < NA8) { u32x4 w; w.x = cvtpk(a[q][0], a[q][1]); w.y = cvtpk(a[q][2], a[q][3]); w.z = cvtpk(b[q][0], b[q][1]); w.w = cvtpk(b[q][2], b[q][3]);
                    __builtin_nontemporal_store(w, (u32x4*)(pb + i * 8)); } }
            }
        }
    }
    if (IN(0) && IN(1)) { cg::this_grid().sync(); xbar = xcd_barrier_post((unsigned*)(ws + WS_BAR), xst); }

    if (IN(1)) {
        pg8::Gemm g{XN, (const bf16_t*)(ws + WS_WIN), DM, DM, DM, 0, MTOT, AB_IN}; pg8::StaticOrder S; S.init(MTOT, AB_IN, G, bx);
        pg8::EpiProj E{proj, (const float*)(ws + WS_CTL + 4096)};
        pg8::gemm_phase<pg8::EpiProj>(lds, g, S, E);
    }
    SEAM(1);


    if (IN(3)) {
        FRESH_IDS;
        LAS float* ctlf = (LAS float*)(lds + att::CTL_OFF); LAS unsigned* ctlu = (LAS unsigned*)(lds + att::CTL_OFF);
        if (wave == 0) {
            const float a = args.in[10][lane] * args.in[11][lane], b = args.in[12][lane] * args.in[13][lane];
            const float sa = wave_sum(a), sb = wave_sum(b);
            float gq = fabsf(args.in[8][lane]), gk = fabsf(args.in[9][lane]), aq = fabsf(args.in[6][lane]), ak = fabsf(args.in[7][lane]);
#pragma unroll
            for (int o = 1; o < 64; o <<= 1) { gq = fmaxf(gq, __shfl_xor(gq, o)); gk = fmaxf(gk, __shfl_xor(gk, o)); aq = fmaxf(aq, __shfl_xor(aq, o)); ak = fmaxf(ak, __shfl_xor(ak, o)); }
            if (lane == 0) { ctlf[1] = __expf(sa) - __expf(sb) + 0.2f;
                ctlf[3] = 8.0f * gq * gk * LOG2E * 1.02f;
                ctlf[4] = 8.0f * aq * ak * LOG2E * 1.02f;
                ctlf[2] = 2.0f * (8.0f * gq * gk * LOG2E * 1.02f) + 80.0f; }
        }
        __syncthreads();
        const float lam = __uint_as_float(__builtin_amdgcn_readfirstlane(__float_as_uint(ctlf[1]))), margin2 = __uint_as_float(__builtin_amdgcn_readfirstlane(__float_as_uint(ctlf[2])));
        const float mfixB = __uint_as_float(__builtin_amdgcn_readfirstlane(__float_as_uint(ctlf[3]))), mfixA = __uint_as_float(__builtin_amdgcn_readfirstlane(__float_as_uint(ctlf[4])));
        const float* subln = args.in[14];
        bf16_t* O = XN;
        unsigned* qctr = (unsigned*)(ws + WS_CTL);
        constexpr int NU = 256 + 1024 + 3 * 256 + 2048 + 2048;
        if (threadIdx.x == 0) ctlu[0] = atomicAdd(qctr, 1u);
        __syncthreads();
        int u_next = (int)__builtin_amdgcn_readfirstlane(ctlu[0]);
        __syncthreads();
        for (;;) {
            int u = u_next;
            if (u >= NU) break;
            unsigned nxt = 0u;
            if (threadIdx.x == 0) nxt = atomicAdd(qctr, 1u);
            int kind, hd, qb, seq, S; long row0;
            if (u < 256) { kind = 1; hd = 3; qb = u & 127; seq = u >> 7; S = S_PROMPT; row0 = (long)seq * S_PROMPT; }
            else if (u < 1280) { u -= 256; kind = 0; qb = u & 63; hd = (u >> 6) & 7; seq = u >> 9; S = S_PROMPT; row0 = (long)seq * S_PROMPT; }
            else if (u < 2048) { u -= 1280; kind = 1; hd = 2 - (u >> 8); u &= 255; qb = u & 127; seq = u >> 7; S = S_PROMPT; row0 = (long)seq * S_PROMPT; }
            else if (u < 4096) { u -= 2048; kind = 1; qb = u & 15; hd = 3 - ((u >> 4) & 3); seq = u >> 6; S = S_SAMPLE; row0 = (long)M_PROMPT + (long)seq * S_SAMPLE; }
            else { u -= 4096; kind = 0; qb = u & 7; hd = (u >> 3) & 7; seq = u >> 6; S = S_SAMPLE; row0 = (long)M_PROMPT + (long)seq * S_SAMPLE; }
            if (kind == 1) {
                const float slope2 = exp2f(-2.0f * (float)(hd + 1)) * LOG2E;
                const int D = (int)ceilf(margin2 / slope2);
                const int q0 = qb * 128, NT = S / 64;
                int t_lo = (q0 - 63 - D >= 0) ? ((q0 - 63 - D) / 64 + 1) : 0;
                int t_hi = (q0 + 127 + D) / 64 + 1; if (t_hi > NT) t_hi = NT;
                att::attn_b_unit(lds, proj, O, row0, S, hd, qb, lam, subln, slope2, t_lo, t_hi, mfixB, args.in[8]);
            } else {
                att::attn_a_unit(lds, proj, O, row0, S, hd, qb, mfixA, args.in[6]);
            }
            if (threadIdx.x == 0) ctlu[0] = nxt;
            __syncthreads();
            u_next = (int)__builtin_amdgcn_readfirstlane(ctlu[0]);
            __syncthreads();
        }
    }
    SEAM(3);

    if (IN(4)) {
        pg8::Gemm g{XN, (const bf16_t*)(ws + WS_WO), DM, DM, DM, 0, MTOT, DM}; pg8::StaticOrder S; S.init(MTOT, DM, G, bx);
        pg8::EpiResid<false> E{x_prompt, x_sample, M_PROMPT, nullptr, (bf16_t*)(ws + WS_H1B), (float*)(ws + WS_SS1)};
        pg8::gemm_phase<pg8::EpiResid<false>>(lds, g, S, E);
    }
    SEAM(4);

    if (IN(5)) {
        { pg8::Gemm g{(const bf16_t*)(ws + WS_PB0), (const bf16_t*)(ws + WS_WP0), PLE, PLE, PLE, 0, MTOT, DM}; pg8::StaticOrder S; S.init(MTOT, DM, G, bx);
          pg8::EpiBf16S E{(bf16_t*)(ws + WS_PP), DM, nullptr};
          pg8::gemm_phase<pg8::EpiBf16S>(lds, g, S, E); }
        { pg8::Gemm g{(const bf16_t*)(ws + WS_H1B), (const bf16_t*)(ws + WS_WG0), DM, DM, DM, 0, MTOT, DM}; pg8::StaticOrder S; S.init(MTOT, DM, G, bx);
          pg8::EpiGate E{(const bf16_t*)(ws + WS_H1B), (const bf16_t*)(ws + WS_PP), (const float*)(ws + WS_SS1), XN, (float*)(ws + WS_SS2), nullptr};
          pg8::gemm_phase<pg8::EpiGate>(lds, g, S, E); }
    }
    SEAM(5);

    if (IN(6)) {
        pg8::Gemm g{XN, (const bf16_t*)(ws + WS_WIC), DM, DM, DM, 0, MTOT, 2048}; pg8::StaticOrder S; S.init(MTOT, 2048, G, bx);
        pg8::EpiBf16S E{(bf16_t*)(ws + WS_UG), 2048, (const float*)(ws + WS_SS2)};
        pg8::gemm_phase<pg8::EpiBf16S>(lds, g, S, E);
    }
    SEAM(6);

    if (IN(7)) {
        FRESH_IDS;
        const bf16_t* ug = (const bf16_t*)(ws + WS_UG); bf16_t* pool = (bf16_t*)(ws + WS_POOL);
        pg8::StaticOrder SP; SP.init(MTOT, DM, G, bx);
        pg8::Unit pu;
        for (int i = 0; SP.next(i, pu); ++i) {
            const int gi = pu.pn, run = pu.pm * 16 + wave * 2 + (lane >> 5), col = gi * 256 + (lane & 31) * 8;
            const int m0 = run * 16;
            int sb, S;
            if (m0 < M_PROMPT) { sb = m0 & ~(S_PROMPT - 1); S = S_PROMPT; } else { sb = M_PROMPT + ((m0 - M_PROMPT) & ~(S_SAMPLE - 1)); S = S_SAMPLE; }
            const int t0 = m0 - sb;
            switch (gi) {
                case 0: pool_run<1, 16>(ug, pool, sb, S, t0, col); break;
                case 1: pool_run<2, 16>(ug, pool, sb, S, t0, col); break;
                case 2: pool_run<4, 8>(ug, pool, sb, S, t0, col); asm volatile("" ::: "memory"); pool_run<4, 8>(ug, pool, sb, S, t0 + 8, col); break;
                default: pool_run<8, 8>(ug, pool, sb, S, t0, col); asm volatile("" ::: "memory"); pool_run<8, 8>(ug, pool, sb, S, t0 + 8, col); break;
            }
        }
    }
    if (IN(7) && IN(8)) { asm volatile("s_waitcnt vmcnt(0)" ::: "memory"); __syncthreads(); }

    if (IN(8)) {
        pg8::Gemm g{(const bf16_t*)(ws + WS_POOL), (const bf16_t*)(ws + WS_WGRP), DM, 256, 256, 256, MTOT, DM}; pg8::StaticOrder S; S.init(MTOT, DM, G, bx);
        pg8::EpiGrp E{(bf16_t*)outp, (const bf16_t*)(ws + WS_UG), args.in[18]};
        pg8::gemm_phase<pg8::EpiGrp>(lds, g, S, E);
    }
    SEAM(8);

    if (IN(9)) {
        pg8::Gemm g{(const bf16_t*)outp, (const bf16_t*)(ws + WS_WOC), DM, DM, DM, 0, MTOT, DM}; pg8::StaticOrder S; S.init(MTOT, DM, G, bx);
        pg8::EpiResid<true> E{nullptr, nullptr, 0, XN, (bf16_t*)(ws + WS_H3B), (float*)(ws + WS_SS3)};
        pg8::gemm_phase<pg8::EpiResid<true>>(lds, g, S, E);
    }
    SEAM(9);

    if (IN(10)) {
        { pg8::Gemm g{(const bf16_t*)(ws + WS_PB1), (const bf16_t*)(ws + WS_WP1), PLE, PLE, PLE, 0, MTOT, DM}; pg8::StaticOrder S; S.init(MTOT, DM, G, bx);
          pg8::EpiBf16S E{(bf16_t*)(ws + WS_PP1), DM, nullptr};
          pg8::gemm_phase<pg8::EpiBf16S>(lds, g, S, E); }
        { pg8::Gemm g{(const bf16_t*)(ws + WS_H3B), (const bf16_t*)(ws + WS_WG1), DM, DM, DM, 0, MTOT, DM}; pg8::StaticOrder S; S.init(MTOT, DM, G, bx);
          pg8::EpiGate E{(const bf16_t*)(ws + WS_H3B), (const bf16_t*)(ws + WS_PP1), (const float*)(ws + WS_SS3), nullptr, nullptr, outp};
          pg8::gemm_phase<pg8::EpiGate>(lds, g, S, E); }
    }
#undef IN
#undef SEAM
}

constexpr int LDS_BYTES = 147456;
constexpr int N_PHASES = 11;

extern "C" void kernel_launch(void* const* d_in, const int* in_sizes, int n_in, void* d_out, int out_size, void* d_ws, size_t ws_size, hipStream_t stream) {
    static int grid = 0;
    if (grid == 0) {
        if (n_in != 23 || out_size != MTOT * DM || ws_size < WS_END) { fprintf(stderr, "kernel_launch: unexpected shapes (n_in %d out %d ws %zu)\n", n_in, out_size, ws_size); grid = -1; return; }
        int dev = 0, cus = 0, per_cu = 0;
        hipGetDevice(&dev);
        hipDeviceGetAttribute(&cus, hipDeviceAttributeMultiprocessorCount, dev);
        hipFuncSetAttribute((const void*)mega_fwd, hipFuncAttributeMaxDynamicSharedMemorySize, LDS_BYTES);
        hipOccupancyMaxActiveBlocksPerMultiprocessor(&per_cu, (const void*)mega_fwd, 512, LDS_BYTES);
        if (per_cu < 1) { fprintf(stderr, "kernel_launch: occupancy query says %d blocks per CU\n", per_cu); per_cu = 1; }
        (void)hipGetLastError();
        grid = cus * 1;
    }
    if (grid < 0) return;
    Args a{};
    for (int i = 0; i < 23; ++i) a.in[i] = (const float*)d_in[i];
    a.out = (float*)d_out; a.ws = (unsigned char*)d_ws;
#if MK_ONE_LAUNCH
#ifdef PROBE_LO
    for (int li = 0; li < 2; ++li) {
        a.ph_lo = li ? PROBE_LO : 0; a.ph_hi = li ? N_PHASES : PROBE_HI;
        if (li) { hipMemsetAsync((char*)d_ws + WS_CTL, 0, 4, stream); hipMemsetAsync((char*)d_ws + WS_BAR, 0, XCD_BAR_WORDS * 4, stream); }
        void* kargs[] = {&a};
        hipError_t e = hipLaunchCooperativeKernel((const void*)mega_fwd, dim3(grid), dim3(512), kargs, LDS_BYTES, stream);
        if (e != hipSuccess) fprintf(stderr, "cooperative launch failed: %s (grid %d)\n", hipGetErrorString(e), grid);
    }
#else
    a.ph_lo = 0; a.ph_hi = N_PHASES;
    void* kargs[] = {&a};
    hipError_t e = hipLaunchCooperativeKernel((const void*)mega_fwd, dim3(grid), dim3(512), kargs, LDS_BYTES, stream);
    if (e != hipSuccess) fprintf(stderr, "cooperative launch failed: %s (grid %d)\n", hipGetErrorString(e), grid);
#endif
#else
    for (int p = 0; p < N_PHASES; ++p) { a.ph_lo = p; a.ph_hi = p + 1; hipLaunchKernelGGL(mega_fwd, dim3(grid), dim3(512), LDS_BYTES, stream, a); }
#endif
}
```

```cpp
#include <hip/hip_runtime.h>
#include <hip/hip_cooperative_groups.h>
#include <cstdio>
#include <cstdint>
namespace cg = cooperative_groups;

#ifndef MK_ONE_LAUNCH
#define MK_ONE_LAUNCH 1
#endif

#define LAS __attribute__((address_space(3)))
typedef unsigned short bf16_t;
typedef short bf16x8 __attribute__((ext_vector_type(8)));
typedef short s16x4 __attribute__((ext_vector_type(4)));
typedef float f32x4 __attribute__((ext_vector_type(4)));
typedef float f32x2 __attribute__((ext_vector_type(2)));
typedef float f32x16 __attribute__((ext_vector_type(16)));
typedef unsigned u32x4 __attribute__((ext_vector_type(4)));
typedef unsigned u32x2 __attribute__((ext_vector_type(2)));
typedef __bf16 bf16x2_t __attribute__((ext_vector_type(2)));

constexpr int DM = 1024;
constexpr int M_PROMPT = 2 * 16384, M_SAMPLE = 32 * 2048, MTOT = M_PROMPT + M_SAMPLE;
constexpr int S_PROMPT = 16384, S_SAMPLE = 2048;
constexpr int PLE = 256;
constexpr int AB_IN = 3328;
constexpr float EPS = 1e-6f;
constexpr float LOG2E = 1.4426950408889634f;
constexpr float QSCALE = 0.125f * LOG2E;

constexpr size_t MiB = 1u << 20;
constexpr size_t UNIT = (size_t)MTOT * DM * 2;
constexpr size_t WS_PROJ = 0;
constexpr size_t WS_XN = 624 * MiB;
constexpr size_t WS_PB0 = 816 * MiB, WS_PB1 = 864 * MiB;
constexpr size_t WS_W = 912 * MiB;
constexpr size_t WS_WIN = WS_W;
constexpr size_t WS_WO = WS_WIN + (size_t)3328 * 1024 * 2;
constexpr size_t WS_WG0 = WS_WO + 2 * MiB, WS_WG1 = WS_WG0 + 2 * MiB;
constexpr size_t WS_WP0 = WS_WG1 + 2 * MiB, WS_WP1 = WS_WP0 + MiB / 2;
constexpr size_t WS_WIC = WS_WP1 + MiB / 2;
constexpr size_t WS_WGRP = WS_WIC + 4 * MiB;
constexpr size_t WS_WOC = WS_WGRP + MiB / 2;
constexpr size_t WS_SS1 = 934 * MiB, WS_SS2 = 940 * MiB, WS_SS3 = 946 * MiB;
constexpr size_t WS_CTL = 952 * MiB;
constexpr size_t WS_BAR = 952 * MiB + 65536;
constexpr size_t WS_END = 953 * MiB;
static_assert(WS_WOC + 2 * MiB <= WS_SS1, "ws map");
constexpr size_t WS_H1B = 0;
constexpr size_t WS_PP = UNIT;
constexpr size_t WS_UG = 0;
constexpr size_t WS_POOL = 2 * UNIT;
constexpr size_t WS_H3B = 2 * UNIT;
constexpr size_t WS_PP1 = 0;
static_assert(3 * UNIT <= WS_XN, "overlay");

__device__ __forceinline__ int fresh_tid() { int t = threadIdx.x; asm volatile("" : "+v"(t)); return t; }
__device__ __forceinline__ unsigned cvtpk(float lo, float hi) { f32x2 v = {lo, hi}; bf16x2_t b = __builtin_convertvector(v, bf16x2_t); return __builtin_bit_cast(unsigned, b); }
__device__ __forceinline__ float bf_lo(unsigned u) { return __uint_as_float(u << 16); }
__device__ __forceinline__ float bf_hi(unsigned u) { return __uint_as_float(u & 0xffff0000u); }
__device__ __forceinline__ float silu_f(float g) { return g * __builtin_amdgcn_rcpf(1.0f + __expf(-g)); }

namespace pg8 {
#define PG8_LAS __attribute__((address_space(3)))
constexpr int BM = 256, BK = 64, HALF = 128, HTB = HALF * BK * 2, STAGE_BYTES = 8 * HTB, NXCD = 8, WGM = 4;

__host__ __device__ __forceinline__ int lds_byte(int r, int c) { const int st = (r >> 4) * 2 + (c >> 5), rr = r & 15, cc = c & 31, ob = rr * 64 + cc * 2; return st * 1024 + (ob ^ (((ob >> 9) & 1) << 5)); }
__host__ __device__ __forceinline__ void stage_rc(int b, int& R, int& C) { const int st = b / 1024, sb = b % 1024, swz = sb ^ (((sb >> 9) & 1) << 5); R = (st >> 1) * 16 + swz / 64; C = (st & 1) * 32 + (swz % 64) / 2; }
__host__ __device__ __forceinline__ int perm32(int rho) { const int n = rho >> 4, i = rho & 15; return 8 * (i >> 2) + 4 * n + (i & 3); }

struct Unit { int pm, pn; };
struct Gemm { const bf16_t* A; const bf16_t* Bt; int lda, ldb, K, a_koff_pn; int M, N; };

struct StaticOrder {
    int nM, nN, nwg, G, c;
    __host__ __device__ void init(int M, int N, int G_, int c_) { nM = M / BM; nN = N / BM; nwg = nM * nN; G = G_; c = c_; }
    __host__ __device__ __forceinline__ bool next(int i, Unit& u) const {
        const long L = (long)i * G + c; if (L >= nwg) return false;
        int wgid = (int)L; { const int q = nwg / NXCD, r = nwg % NXCD, xcd = wgid % NXCD, off = wgid / NXCD; wgid = (xcd < r ? xcd * (q + 1) : r * (q + 1) + (xcd - r) * q) + off; }
        const int nig = WGM * nN, gid = wgid / nig, fm = gid * WGM, gsz = (nM - fm) < WGM ? (nM - fm) : WGM;
        u.pm = fm + ((wgid % nig) % gsz); u.pn = (wgid % nig) / gsz; return true;
    }
};

__device__ __forceinline__ float row_rstd16(const float* ss, int row, int fq) {
    const f32x4 a = *(const f32x4*)(ss + (size_t)row * 16 + 4 * fq);
    float s = (a[0] + a[1]) + (a[2] + a[3]);
    s += __shfl_xor(s, 16); s += __shfl_xor(s, 32);
    return __builtin_amdgcn_rsqf(s * (1.0f / 1024.0f) + EPS);
}

struct EpiBf16S {
    static constexpr bool PERM = true;
    bf16_t* O; int ldc; const float* ss;
    __device__ __forceinline__ void operator()(const f32x4 (&acc)[2][2][4][2], const Unit& u, int wr, int wc, int fr, int fq) const {
        const int row0 = u.pm * BM + wr * 64 + fr, col0 = u.pn * BM + wc * 32 + 8 * fq;
#pragma unroll
        for (int ai = 0; ai < 2; ++ai)
#pragma unroll
            for (int m = 0; m < 4; ++m) {
                const int row = row0 + ai * HALF + m * 16;
                const float sc = ss ? row_rstd16(ss, row, fq) : 1.0f;
                bf16_t* rowp = O + (size_t)row * ldc + col0;
#pragma unroll
                for (int bj = 0; bj < 2; ++bj) { const f32x4 v0 = acc[ai][bj][m][0] * sc, v1 = acc[ai][bj][m][1] * sc;
                    u32x4 w; w.x = cvtpk(v0[0], v0[1]); w.y = cvtpk(v0[2], v0[3]); w.z = cvtpk(v1[0], v1[1]); w.w = cvtpk(v1[2], v1[3]);
                    *(u32x4*)(rowp + bj * HALF) = w; }
            }
    }
};
struct EpiProj {
    static constexpr bool PERM = true;
    bf16_t* O; const float* wtab;
    __device__ __forceinline__ void operator()(const f32x4 (&acc)[2][2][4][2], const Unit& u, int wr, int wc, int fr, int fq) const {
        const int row0 = u.pm * BM + wr * 64 + fr;
        const bool ktile = (u.pn <= 2) || (u.pn >= 5 && u.pn <= 8);
        if (!ktile) {
            const int col0 = u.pn * BM + wc * 32 + 8 * fq;
#pragma unroll
            for (int ai = 0; ai < 2; ++ai)
#pragma unroll
                for (int m = 0; m < 4; ++m) { bf16_t* rowp = O + (size_t)(row0 + ai * HALF + m * 16) * AB_IN + col0;
#pragma unroll
                    for (int bj = 0; bj < 2; ++bj) { const f32x4 v0 = acc[ai][bj][m][0], v1 = acc[ai][bj][m][1];
                        u32x4 w; w.x = cvtpk(v0[0], v0[1]); w.y = cvtpk(v0[2], v0[3]); w.z = cvtpk(v1[0], v1[1]); w.w = cvtpk(v1[2], v1[3]); *(u32x4*)(rowp + bj * HALF) = w; } }
            return;
        }
        const bool norm = (u.pn != 2) || (wc < 2), rope = (u.pn < 2) || ((u.pn == 2) && (wc < 2));
        const float* wp = wtab + 64 * ((u.pn >= 2) + (u.pn >= 5) + (u.pn >= 7));
        const float qs = (u.pn < 2 || u.pn == 5 || u.pn == 6) ? QSCALE : 1.0f;
        const float sgn = (fq & 2) ? 1.0f : -1.0f;
        f32x4 wv[2][2];
#pragma unroll
        for (int bj = 0; bj < 2; ++bj) { wv[bj][0] = *(const f32x4*)(wp + 32 * bj + 8 * fq); wv[bj][1] = *(const f32x4*)(wp + 32 * bj + 8 * fq + 4); }
        const int colb = u.pn * BM + 64 * wc + 8 * fq;
#pragma unroll
        for (int ai = 0; ai < 2; ++ai)
#pragma unroll
            for (int m = 0; m < 4; ++m) {
                int row = row0 + ai * HALF + m * 16; asm volatile("" : "+v"(row));
                float v[2][8]; float ss = 0.f;
#pragma unroll
                for (int bj = 0; bj < 2; ++bj)
#pragma unroll
                    for (int k = 0; k < 8; ++k) { v[bj][k] = acc[ai][bj][m][k >> 2][k & 3]; ss += v[bj][k] * v[bj][k]; }
                if (norm) {
                    ss += __shfl_xor(ss, 16); ss += __shfl_xor(ss, 32);
                    const float rstd = __builtin_amdgcn_rsqf(ss * (1.0f / 64.0f) + EPS);
#pragma unroll
                    for (int bj = 0; bj < 2; ++bj) { const f32x4 w0 = wv[bj][0], w1 = wv[bj][1];
#pragma unroll
                        for (int k = 0; k < 4; ++k) { v[bj][k] *= rstd * w0[k]; v[bj][4 + k] *= rstd * w1[k]; } }
                }
                if (rope) {
                    const int t = (row < M_PROMPT) ? (row & (S_PROMPT - 1)) : ((row - M_PROMPT) & (S_SAMPLE - 1));
#pragma unroll
                    for (int bj = 0; bj < 2; ++bj) { const float pos = (float)(bj == 0 ? (t >> 6) : (t & 63));
#pragma unroll
                        for (int k = 0; k < 8; ++k) { const float a = pos * exp2f(-(float)(8 * (fq & 1) + k) * (13.287712379549449f / 16.0f));     const float pr = __shfl_xor(v[bj][k], 32); v[bj][k] = v[bj][k] * __cosf(a) + sgn * pr * __sinf(a); } }
                }
#pragma unroll
                for (int bj = 0; bj < 2; ++bj) { u32x4 w; w.x = cvtpk(v[bj][0] * qs, v[bj][1] * qs); w.y = cvtpk(v[bj][2] * qs, v[bj][3] * qs); w.z = cvtpk(v[bj][4] * qs, v[bj][5] * qs); w.w = cvtpk(v[bj][6] * qs, v[bj][7] * qs);
                    *(u32x4*)(O + (size_t)row * AB_IN + colb + 32 * bj) = w; }
                asm volatile("" ::: "memory");
            }
    }
};
struct EpiF32 {
    static constexpr bool PERM = false;
    bf16_t* O;
    __device__ __forceinline__ void operator()(const f32x4 (&acc)[2][2][4][2], const Unit& u, int wr, int wc, int fr, int fq) const {
        const int row0 = u.pm * BM + wr * 64 + fr, col0 = u.pn * BM + wc * 32 + 4 * fq;
#pragma unroll
        for (int ai = 0; ai < 2; ++ai)
#pragma unroll
            for (int m = 0; m < 4; ++m) { bf16_t* rowp = O + (size_t)(row0 + ai * HALF + m * 16) * DM + col0;
#pragma unroll
                for (int bj = 0; bj < 2; ++bj)
#pragma unroll
                    for (int n = 0; n < 2; ++n) { const f32x4 v = acc[ai][bj][m][n]; u32x2 w; w.x = cvtpk(v[0], v[1]); w.y = cvtpk(v[2], v[3]); *(u32x2*)(rowp + bj * HALF + n * 16) = w; } }
    }
};
template <bool BF16BASE> struct EpiResid {
    static constexpr bool PERM = true;
    const float* baseA; const float* baseB; int split; const bf16_t* baseH; bf16_t* hb; float* ss;
    __device__ __forceinline__ void operator()(const f32x4 (&acc)[2][2][4][2], const Unit& u, int wr, int wc, int fr, int fq) const {
        const int row0 = u.pm * BM + wr * 64 + fr, col0 = u.pn * BM + wc * 32 + 8 * fq;
        float sqv[8];
#pragma unroll
        for (int ai = 0; ai < 2; ++ai)
#pragma unroll
            for (int m = 0; m < 4; ++m) {
                const int row = row0 + ai * HALF + m * 16;
                const size_t off = (size_t)row * DM + col0; float sq = 0.f;
                const float* bp = BF16BASE ? nullptr : ((row < split ? baseA + (size_t)row * DM : baseB + (size_t)(row - split) * DM) + col0);
#pragma unroll
                for (int bj = 0; bj < 2; ++bj) { f32x4 b0, b1;
                    if (BF16BASE) { const u32x4 r = *(const u32x4*)(baseH + off + bj * HALF); b0 = (f32x4){bf_lo(r.x), bf_hi(r.x), bf_lo(r.y), bf_hi(r.y)}; b1 = (f32x4){bf_lo(r.z), bf_hi(r.z), bf_lo(r.w), bf_hi(r.w)}; }
                    else { b0 = *(const f32x4*)(bp + bj * HALF); b1 = *(const f32x4*)(bp + bj * HALF + 4); }
                    const f32x4 v0 = acc[ai][bj][m][0] + b0, v1 = acc[ai][bj][m][1] + b1;
                    u32x4 w; w.x = cvtpk(v0[0], v0[1]); w.y = cvtpk(v0[2], v0[3]); w.z = cvtpk(v1[0], v1[1]); w.w = cvtpk(v1[2], v1[3]); *(u32x4*)(hb + off + bj * HALF) = w;
                    sq += ((v0[0] * v0[0] + v0[1] * v0[1]) + (v0[2] * v0[2] + v0[3] * v0[3])) + ((v1[0] * v1[0] + v1[1] * v1[1]) + (v1[2] * v1[2] + v1[3] * v1[3])); }
                sq += __shfl_xor(sq, 16); sq += __shfl_xor(sq, 32);
                sqv[ai * 4 + m] = sq;
                if (m & 1) asm volatile("" ::: "memory");
            }
#pragma unroll
        for (int h = 0; h < 2; ++h) { const float val = (fq == 0) ? sqv[4 * h] : (fq == 1) ? sqv[4 * h + 1] : (fq == 2) ? sqv[4 * h + 2] : sqv[4 * h + 3];
            ss[(size_t)(row0 + h * HALF + fq * 16) * 16 + u.pn * 4 + wc] = val; }
    }
};
struct EpiGate {
    static constexpr bool PERM = true;
    const bf16_t* hin; const bf16_t* pp; const float* ssin; bf16_t* hb; float* ssout; float* outf;
    __device__ __forceinline__ void operator()(const f32x4 (&acc)[2][2][4][2], const Unit& u, int wr, int wc, int fr, int fq) const {
        const int row0 = u.pm * BM + wr * 64 + fr, col0 = u.pn * BM + wc * 32 + 8 * fq;
        float sqv[8];
#pragma unroll
        for (int ai = 0; ai < 2; ++ai)
#pragma unroll
            for (int m = 0; m < 4; ++m) {
                int row = row0 + ai * HALF + m * 16; asm volatile("" : "+v"(row));
                const float rstd = row_rstd16(ssin, row, fq);
                const size_t off = (size_t)row * DM + col0; float sq = 0.f;
#pragma unroll
                for (int bj = 0; bj < 2; ++bj) { const size_t o2 = off + bj * HALF;
                    const u32x4 hr = *(const u32x4*)(hin + o2), pr = *(const u32x4*)(pp + o2);
                    const float h[8] = {bf_lo(hr.x), bf_hi(hr.x), bf_lo(hr.y), bf_hi(hr.y), bf_lo(hr.z), bf_hi(hr.z), bf_lo(hr.w), bf_hi(hr.w)};
                    const float p[8] = {bf_lo(pr.x), bf_hi(pr.x), bf_lo(pr.y), bf_hi(pr.y), bf_lo(pr.z), bf_hi(pr.z), bf_lo(pr.w), bf_hi(pr.w)};
                    float v[8];
#pragma unroll
                    for (int i = 0; i < 8; ++i) { const float a = acc[ai][bj][m][i >> 2][i & 3] * rstd; v[i] = h[i] + p[i] * __builtin_amdgcn_rcpf(1.0f + __expf(-a)); sq += v[i] * v[i]; }
                    if (outf) { __builtin_nontemporal_store((f32x4){v[0], v[1], v[2], v[3]}, (f32x4*)(outf + o2)); __builtin_nontemporal_store((f32x4){v[4], v[5], v[6], v[7]}, (f32x4*)(outf + o2 + 4)); }
                    if (hb) { u32x4 w; w.x = cvtpk(v[0], v[1]); w.y = cvtpk(v[2], v[3]); w.z = cvtpk(v[4], v[5]); w.w = cvtpk(v[6], v[7]); *(u32x4*)(hb + o2) = w; } }
                sq += __shfl_xor(sq, 16); sq += __shfl_xor(sq, 32);
                sqv[ai * 4 + m] = sq;
                if (m & 1) asm volatile("" ::: "memory");
            }
        if (ssout) {
#pragma unroll
            for (int h = 0; h < 2; ++h) { const float val = (fq == 0) ? sqv[4 * h] : (fq == 1) ? sqv[4 * h + 1] : (fq == 2) ? sqv[4 * h + 2] : sqv[4 * h + 3];
                ssout[(size_t)(row0 + h * HALF + fq * 16) * 16 + u.pn * 4 + wc] = val; }
        }
    }
};
struct EpiGrp {
    static constexpr bool PERM = true;
    bf16_t* Z; const bf16_t* ug; const float* cs;
    __device__ __forceinline__ void operator()(const f32x4 (&acc)[2][2][4][2], const Unit& u, int wr, int wc, int fr, int fq) const {
        const int row0 = u.pm * BM + wr * 64 + fr, col0 = u.pn * BM + wc * 32 + 8 * fq;
        f32x4 csv[2][2];
#pragma unroll
        for (int bj = 0; bj < 2; ++bj) { csv[bj][0] = *(const f32x4*)(cs + col0 + bj * HALF); csv[bj][1] = *(const f32x4*)(cs + col0 + bj * HALF + 4); }
#pragma unroll
        for (int ai = 0; ai < 2; ++ai)
#pragma unroll
            for (int m = 0; m < 4; ++m) {
                const int row = row0 + ai * HALF + m * 16;
#pragma unroll
                for (int bj = 0; bj < 2; ++bj) { const int col = col0 + bj * HALF;
                    const u32x4 g8 = *(const u32x4*)(ug + (size_t)row * 2048 + 1024 + col);
                    const f32x4 c0 = csv[bj][0], c1 = csv[bj][1];
                    const f32x4 v0 = acc[ai][bj][m][0] * c0, v1 = acc[ai][bj][m][1] * c1;
                    u32x4 w;
                    w.x = cvtpk(v0[0] * silu_f(bf_lo(g8.x)), v0[1] * silu_f(bf_hi(g8.x)));
                    w.y = cvtpk(v0[2] * silu_f(bf_lo(g8.y)), v0[3] * silu_f(bf_hi(g8.y)));
                    w.z = cvtpk(v1[0] * silu_f(bf_lo(g8.z)), v1[1] * silu_f(bf_hi(g8.z)));
                    w.w = cvtpk(v1[2] * silu_f(bf_lo(g8.w)), v1[3] * silu_f(bf_hi(g8.w)));
                    *(u32x4*)(Z + (size_t)row * DM + col) = w; }
                asm volatile("" ::: "memory");
            }
    }
};

template <class Epi, bool ALIGN_EPI = true>
__device__ __forceinline__ void gemm_phase(PG8_LAS unsigned char* lds, const Gemm g, const StaticOrder& S, const Epi& E) {
    const int tid = fresh_tid(), wid = __builtin_amdgcn_readfirstlane(tid >> 6), lane = tid & 63, wr = wid >> 2, wc = wid & 3, fr = lane & 15, fq = lane >> 4;
    const int K = g.K, nt = K / BK;
    unsigned voffA[2], voffB[2];
#pragma unroll
    for (int i = 0; i < 2; ++i) { int R, C; stage_rc(tid * 16 + i * 8192, R, C); const int Rb = Epi::PERM ? ((R & ~31) + perm32(R & 31)) : R;
        voffA[i] = (unsigned)(R * g.lda + C) * 2u; voffB[i] = (unsigned)(Rb * g.ldb + C) * 2u; }
    const size_t kstep = (size_t)(BK * 2);
    const size_t hstepA = (size_t)HALF * g.lda * 2, hstepB = (size_t)HALF * g.ldb * 2;
    const size_t tstepA = 2 * hstepA, tstepB = 2 * hstepB;
    const unsigned ldsw = (unsigned)wid * 1024u;
    const int aoff = lds_byte(wr * 64 + fr, fq * 8), boff = lds_byte(wc * 32 + fr, fq * 8);
#define PG8_SA(b, h) (((b) * 2 + (h)) * HTB)
#define PG8_SB(b, h) ((4 + (b) * 2 + (h)) * HTB)
#define PG8_STAGE(bufoff, gbase, voff) do { _Pragma("unroll") for (int _i = 0; _i < 2; ++_i) \
        __builtin_amdgcn_global_load_lds((const unsigned*)((const char*)(gbase) + (voff)[_i]), (PG8_LAS unsigned*)(lds + (bufoff) + ldsw + _i * 8192), 16, 0, 0); } while (0)
#define PG8_LDA(dst, b, h) do { _Pragma("unroll") for (int m = 0; m < 4; ++m) _Pragma("unroll") for (int k = 0; k < 2; ++k) dst[m][k] = *(const PG8_LAS bf16x8*)(lds + PG8_SA(b, h) + aoff + m * 2048 + k * 1024); } while (0)
#define PG8_LDB(dst, b, h) do { _Pragma("unroll") for (int n = 0; n < 2; ++n) _Pragma("unroll") for (int k = 0; k < 2; ++k) dst[n][k] = *(const PG8_LAS bf16x8*)(lds + PG8_SB(b, h) + boff + n * 2048 + k * 1024); } while (0)
#define PG8_MMA(ai, bj, At, Bt) do { __builtin_amdgcn_s_setprio(1); _Pragma("unroll") for (int m = 0; m < 4; ++m) _Pragma("unroll") for (int n = 0; n < 2; ++n) _Pragma("unroll") for (int k = 0; k < 2; ++k) \
        acc[ai][bj][m][n] = __builtin_amdgcn_mfma_f32_16x16x32_bf16(Bt[n][k], At[m][k], acc[ai][bj][m][n], 0, 0, 0); __builtin_amdgcn_s_setprio(0); } while (0)
#define PG8_WAIT_V(n) asm volatile("s_waitcnt vmcnt(" #n ")" ::: "memory")
#define PG8_WAIT_L(n) asm volatile("s_waitcnt lgkmcnt(" #n ")" ::: "memory")
#define PG8_BAR __builtin_amdgcn_s_barrier()
#define PG8_SCHED __builtin_amdgcn_sched_barrier(0)
    Unit cur, nxt; int ui = 0;
    if (!S.next(0, cur)) return;
    f32x4 acc[2][2][4][2];
#pragma unroll
    for (int a = 0; a < 2; ++a)
#pragma unroll
        for (int b = 0; b < 2; ++b)
#pragma unroll
            for (int m = 0; m < 4; ++m)
#pragma unroll
                for (int n = 0; n < 2; ++n) acc[a][b][m][n] = (f32x4){0.f, 0.f, 0.f, 0.f};
    bf16x8 At[4][2], B0[2][2], B1[2][2];
    const char* cA = (const char*)g.A + (size_t)cur.pm * tstepA + (size_t)cur.pn * g.a_koff_pn * 2; const char* cB = (const char*)g.Bt + (size_t)cur.pn * tstepB;
    PG8_STAGE(PG8_SB(0, 0), cB, voffB); PG8_STAGE(PG8_SB(0, 1), cB + hstepB, voffB); PG8_STAGE(PG8_SA(0, 0), cA, voffA); PG8_STAGE(PG8_SA(0, 1), cA + hstepA, voffA);
    if (wr == 1) PG8_BAR;
    PG8_WAIT_V(2); PG8_BAR;
    PG8_STAGE(PG8_SB(1, 0), cB + kstep, voffB); PG8_STAGE(PG8_SA(1, 0), cA + kstep, voffA); PG8_STAGE(PG8_SB(1, 1), cB + hstepB + kstep, voffB);
    PG8_WAIT_V(6); PG8_BAR;
    for (;;) {
        const bool has_next = S.next(ui + 1, nxt);
        const char* nA = has_next ? (const char*)g.A + (size_t)nxt.pm * tstepA + (size_t)nxt.pn * g.a_koff_pn * 2 : cA; const char* nB = has_next ? (const char*)g.Bt + (size_t)nxt.pn * tstepB : cB;
        for (int t = 0; t < nt; t += 2) {
            const bool last = (t == nt - 2);
            const char* a1 = cA + (size_t)(t + 1) * kstep;
            const char* a2 = last ? nA : cA + (size_t)(t + 2) * kstep; const char* b2 = last ? nB : cB + (size_t)(t + 2) * kstep;
            const char* a3 = a2 + kstep; const char* b3 = b2 + kstep;
            PG8_LDB(B0, 0, 0); PG8_LDB(B1, 0, 1); PG8_SCHED; PG8_LDA(At, 0, 0); PG8_STAGE(PG8_SA(1, 1), a1 + hstepA, voffA);
            PG8_WAIT_V(8); PG8_WAIT_L(0); PG8_BAR; PG8_MMA(0, 0, At, B0); PG8_MMA(0, 1, At, B1); PG8_BAR; PG8_SCHED;
            PG8_LDA(At, 0, 1); PG8_STAGE(PG8_SB(0, 0), b2, voffB); PG8_STAGE(PG8_SB(0, 1), b2 + hstepB, voffB); PG8_STAGE(PG8_SA(0, 0), a2, voffA);
            PG8_WAIT_V(8); PG8_WAIT_L(0); PG8_BAR; PG8_MMA(1, 0, At, B0); PG8_MMA(1, 1, At, B1); PG8_BAR; PG8_SCHED;
            PG8_LDB(B0, 1, 0); PG8_LDB(B1, 1, 1); PG8_SCHED; PG8_LDA(At, 1, 0); PG8_STAGE(PG8_SA(0, 1), a2 + hstepA, voffA);
            PG8_WAIT_V(8); PG8_WAIT_L(0); PG8_BAR; PG8_MMA(0, 0, At, B0); PG8_MMA(0, 1, At, B1); PG8_BAR; PG8_SCHED;
            PG8_LDA(At, 1, 1); PG8_STAGE(PG8_SB(1, 0), b3, voffB); PG8_STAGE(PG8_SB(1, 1), b3 + hstepB, voffB); PG8_STAGE(PG8_SA(1, 0), a3, voffA);
            PG8_WAIT_V(8); PG8_WAIT_L(0); PG8_BAR; PG8_MMA(1, 0, At, B0); PG8_MMA(1, 1, At, B1); PG8_BAR; PG8_SCHED;
        }
        if constexpr (ALIGN_EPI) { if (wr == 0) PG8_BAR; }
        E(acc, cur, wr, wc, fr, fq);
        if (!has_next) break;
#pragma unroll
        for (int a = 0; a < 2; ++a)
#pragma unroll
            for (int b = 0; b < 2; ++b)
#pragma unroll
                for (int m = 0; m < 4; ++m)
#pragma unroll
                    for (int n = 0; n < 2; ++n) acc[a][b][m][n] = (f32x4){0.f, 0.f, 0.f, 0.f};
        cur = nxt; cA = nA; cB = nB; ++ui;
        if constexpr (ALIGN_EPI) { if (wr == 1) PG8_BAR; }
    }
    PG8_WAIT_V(0);
    if constexpr (!ALIGN_EPI) { if (wr == 0) PG8_BAR; }
    PG8_BAR;
#undef PG8_SA
#undef PG8_SB
#undef PG8_STAGE
#undef PG8_LDA
#undef PG8_LDB
#undef PG8_MMA
#undef PG8_WAIT_V
#undef PG8_WAIT_L
#undef PG8_BAR
#undef PG8_SCHED
}
}

namespace att {
typedef short v4i16_t __attribute__((ext_vector_type(4)));
constexpr int KP = 144;
constexpr int VPA = 192, VPB = 320;
constexpr int BUFA = 64 * KP + 64 * VPA;
constexpr int BUFB = 2 * 64 * KP + 64 * VPB;
constexpr int CP = 132;
constexpr int CTL_OFF = 131072;
constexpr float THR = 8.0f;
static_assert(128 * CP * 4 <= 3 * BUFB && 3 * BUFB <= CTL_OFF && 6 * BUFA <= CTL_OFF, "LDS map");

__device__ __forceinline__ s16x4 vtr(const LAS unsigned char* p) { return __builtin_bit_cast(s16x4, __builtin_amdgcn_ds_read_tr16_b64_v4i16((LAS v4i16_t*)p)); }
__device__ __forceinline__ float pair_max(float v) { auto rr = __builtin_amdgcn_permlane32_swap(__float_as_uint(v), __float_as_uint(v), false, false); return fmaxf(__uint_as_float(rr[0]), __uint_as_float(rr[1])); }
__device__ __forceinline__ float pair_sum(float v) { auto rr = __builtin_amdgcn_permlane32_swap(__float_as_uint(v), __float_as_uint(v), false, false); return __uint_as_float(rr[0]) + __uint_as_float(rr[1]); }
__device__ __forceinline__ float max3f(float a, float b, float c) { float r; asm("v_max3_f32 %0, %1, %2, %3" : "=v"(r) : "v"(a), "v"(b), "v"(c)); return r; }
__device__ __forceinline__ bf16x8 pack8(const f32x16& p, int b) {
    u32x4 w; w.x = cvtpk(p[b], p[b + 1]); w.y = cvtpk(p[b + 2], p[b + 3]); w.z = cvtpk(p[b + 4], p[b + 5]); w.w = cvtpk(p[b + 6], p[b + 7]);
    return __builtin_bit_cast(bf16x8, w);
}
#define VFRAG(lo, hi) (bf16x8){lo[0], lo[1], lo[2], lo[3], hi[0], hi[1], hi[2], hi[3]}


__device__ __forceinline__ void q_prep(bf16x8 (&qr)[4], const bf16_t* Qg, const float* w, int hi, bool rope, int tpos) {
    float x[4][8]; float ss = 0.f;
#pragma unroll
    for (int d0 = 0; d0 < 4; ++d0) { const u32x4 raw = *(const u32x4*)(Qg + d0 * 16 + hi * 8);
        x[d0][0] = bf_lo(raw.x); x[d0][1] = bf_hi(raw.x); x[d0][2] = bf_lo(raw.y); x[d0][3] = bf_hi(raw.y); x[d0][4] = bf_lo(raw.z); x[d0][5] = bf_hi(raw.z); x[d0][6] = bf_lo(raw.w); x[d0][7] = bf_hi(raw.w);
#pragma unroll
        for (int j = 0; j < 8; ++j) ss += x[d0][j] * x[d0][j]; }
    ss = pair_sum(ss);
    const float rstd = __builtin_amdgcn_rsqf(ss * (1.0f / 64.0f) + EPS);
#pragma unroll
    for (int d0 = 0; d0 < 4; ++d0) { const f32x4 w0 = *(const f32x4*)(w + d0 * 16 + hi * 8), w1 = *(const f32x4*)(w + d0 * 16 + hi * 8 + 4);
#pragma unroll
        for (int j = 0; j < 4; ++j) { x[d0][j] *= rstd * w0[j]; x[d0][4 + j] *= rstd * w1[j]; } }
    if (rope) {
        const float prow = (float)(tpos >> 6), pcol = (float)(tpos & 63);
#pragma unroll
        for (int j = 0; j < 8; ++j) {
            const float inv = exp2f(-(float)(8 * hi + j) * (13.287712379549449f / 16.0f));
            const float ar = prow * inv, ac = pcol * inv;
            const float cr = __cosf(ar), sr = __sinf(ar), cc = __cosf(ac), sc_ = __sinf(ac);
            const float y0 = x[0][j], y1 = x[1][j], y2 = x[2][j], y3 = x[3][j];
            x[0][j] = y0 * cr - y1 * sr; x[1][j] = y1 * cr + y0 * sr; x[2][j] = y2 * cc - y3 * sc_; x[3][j] = y3 * cc + y2 * sc_;
        }
    }
#pragma unroll
    for (int d0 = 0; d0 < 4; ++d0) { u32x4 wv; wv.x = cvtpk(x[d0][0] * QSCALE, x[d0][1] * QSCALE); wv.y = cvtpk(x[d0][2] * QSCALE, x[d0][3] * QSCALE); wv.z = cvtpk(x[d0][4] * QSCALE, x[d0][5] * QSCALE); wv.w = cvtpk(x[d0][6] * QSCALE, x[d0][7] * QSCALE);
        qr[d0] = __builtin_bit_cast(bf16x8, wv); }
}

__device__ __forceinline__ void qk_tile(f32x16& p0, f32x16& p1, const LAS unsigned char* kb, const bf16x8 (&qr)[4]) {
#pragma unroll
    for (int d0 = 0; d0 < 4; ++d0) {
        const bf16x8 k0 = *(const LAS bf16x8*)(kb + d0 * 32), k1 = *(const LAS bf16x8*)(kb + 32 * KP + d0 * 32);
        p0 = __builtin_amdgcn_mfma_f32_32x32x16_bf16(k0, qr[d0], p0, 0, 0, 0);
        p1 = __builtin_amdgcn_mfma_f32_32x32x16_bf16(k1, qr[d0], p1, 0, 0, 0);
    }
}
__device__ __forceinline__ void qk_tile_c(f32x16& p0, f32x16& p1, const f32x16& negm, const LAS unsigned char* kb, const bf16x8 (&qr)[4]) {
#pragma unroll
    for (int d0 = 0; d0 < 4; ++d0) {
        const bf16x8 k0 = *(const LAS bf16x8*)(kb + d0 * 32), k1 = *(const LAS bf16x8*)(kb + 32 * KP + d0 * 32);
        if (d0 == 0) { p0 = __builtin_amdgcn_mfma_f32_32x32x16_bf16(k0, qr[0], negm, 0, 0, 0); p1 = __builtin_amdgcn_mfma_f32_32x32x16_bf16(k1, qr[0], negm, 0, 0, 0); }
        else { p0 = __builtin_amdgcn_mfma_f32_32x32x16_bf16(k0, qr[d0], p0, 0, 0, 0); p1 = __builtin_amdgcn_mfma_f32_32x32x16_bf16(k1, qr[d0], p1, 0, 0, 0); }
    }
}
__device__ __forceinline__ void softmax_head(f32x16& p0, f32x16& p1, float mref, float& m_run, float& l_run, float& alpha, bool& resc) {
    float ma = max3f(p0[0], p0[1], p1[0]), mb = max3f(p0[2], p0[3], p1[1]); ma = max3f(ma, p1[2], p1[3]);
#pragma unroll
    for (int r = 4; r < 16; r += 4) { ma = max3f(ma, p0[r], p0[r + 1]); mb = max3f(mb, p0[r + 2], p0[r + 3]); ma = max3f(ma, p1[r], p1[r + 1]); mb = max3f(mb, p1[r + 2], p1[r + 3]); }
    float mx = pair_max(fmaxf(ma, mb));
    float shift = m_run - mref;
    const float ex = mx - shift;
    resc = __builtin_amdgcn_ballot_w64(ex > THR) != 0ull;
    alpha = 1.0f;
    if (resc) { const float dl = fmaxf(ex, 0.f); alpha = __builtin_amdgcn_exp2f(-dl); l_run *= alpha; m_run += dl; shift += dl; }
    if (__builtin_amdgcn_ballot_w64(shift != 0.f) != 0ull) {
#pragma unroll
        for (int r = 0; r < 16; ++r) { p0[r] -= shift; p1[r] -= shift; }
    }
}
#define ATT_BAR() asm volatile("s_waitcnt lgkmcnt(0)\n\ts_barrier" ::: "memory")
#define ATT_SCHED(NMFMA, NV) do { __builtin_amdgcn_sched_group_barrier(0x100, 12, 0); __builtin_amdgcn_sched_group_barrier(0x002, 12, 0); _Pragma("unroll") for (int _g = 0; _g < (NMFMA); ++_g) { \
    __builtin_amdgcn_sched_group_barrier(0x100, 2, 0); __builtin_amdgcn_sched_group_barrier(0x008, 1, 0); __builtin_amdgcn_sched_group_barrier(0x002, (NV), 0); } } while (0)

__device__ __forceinline__ void attn_a_unit(LAS unsigned char* lds, const bf16_t* proj, bf16_t* O, long seq_row0, int S, int head, int qblk, float mfix, const float* qnw) {
    const int tid = fresh_tid(), lane = tid & 63, r32 = lane & 31, hi = lane >> 5; const int wid = __builtin_amdgcn_readfirstlane(tid >> 6);
    const int kvh = head >> 2;
    const long qrow = seq_row0 + qblk * 256 + wid * 32 + r32;
    const bf16_t* Qg = proj + qrow * AB_IN + head * 64;
    const int srow = tid >> 3, sch = tid & 7;
    const bf16_t* kld = proj + (seq_row0 + srow) * AB_IN + 512 + kvh * 64 + sch * 8;
    const bf16_t* vld = kld + 128;
    const unsigned kst = srow * KP + sch * 16, vst = 64 * KP + srow * VPA + sch * 16;
    constexpr int SUP = 2 * BUFA;
    const int NS = S / 128;
    u32x4 kr0, vr0, kr1, vr1;
#define A_LOAD(T) do { const size_t go = (size_t)(T) * 128 * AB_IN; kr0 = *(const u32x4*)(kld + go); vr0 = *(const u32x4*)(vld + go); kr1 = *(const u32x4*)(kld + go + (size_t)64 * AB_IN); vr1 = *(const u32x4*)(vld + go + (size_t)64 * AB_IN); } while (0)
#define A_STORE(off) do { *(LAS u32x4*)(lds + (off) + kst) = kr0; *(LAS u32x4*)(lds + (off) + vst) = vr0; *(LAS u32x4*)(lds + (off) + BUFA + kst) = kr1; *(LAS u32x4*)(lds + (off) + BUFA + vst) = vr1; } while (0)
    A_LOAD(0);
    bf16x8 qr[4];
#pragma unroll
    for (int d0 = 0; d0 < 4; ++d0) qr[d0] = *(const bf16x8*)(Qg + d0 * 16 + hi * 8);
    A_STORE(0);
    A_LOAD(1); A_STORE(SUP);
    ATT_BAR();
    f32x16 o0 = {}, o1 = {}; float l_run = 0.f;
    const unsigned kfo = r32 * KP + hi * 16;
    const unsigned vfo = 64 * KP + (4 * hi + ((lane & 15) >> 2)) * VPA + (16 * ((lane >> 4) & 1) + 4 * (lane & 3)) * 2;
    f32x16 sc0, sc1, negm;
#pragma unroll
    for (int r = 0; r < 16; ++r) negm[r] = -mfix;
    asm volatile("" : "+v"(negm));
    qk_tile_c(sc0, sc1, negm, lds + kfo, qr);
    int sV = 0, sK = SUP, sW = 2 * SUP;
    for (int T = 0; T < NS; ++T) {
        A_LOAD(min(T + 2, NS - 1));
#pragma unroll
        for (int sub = 0; sub < 2; ++sub) {
            f32x16 sn0, sn1;
            qk_tile_c(sn0, sn1, negm, lds + (sub == 0 ? sV + BUFA : sK) + kfo, qr);
            float ls = 0.f;
#pragma unroll
            for (int r = 0; r < 16; ++r) { sc0[r] = __builtin_amdgcn_exp2f(sc0[r]); ls += sc0[r]; }
#pragma unroll
            for (int r = 0; r < 16; ++r) { sc1[r] = __builtin_amdgcn_exp2f(sc1[r]); ls += sc1[r]; }
            l_run += ls;
#pragma unroll
            for (int ks = 0; ks < 4; ++ks) {
                const bf16x8 pa = (ks < 2) ? pack8(sc0, 8 * ks) : pack8(sc1, 8 * (ks - 2));
                const LAS unsigned char* vb = lds + sV + sub * BUFA + vfo + ks * 16 * VPA;
                const s16x4 l0 = vtr(vb), h0 = vtr(vb + 8 * VPA), l1 = vtr(vb + 64), h1 = vtr(vb + 8 * VPA + 64);
                o0 = __builtin_amdgcn_mfma_f32_32x32x16_bf16(VFRAG(l0, h0), pa, o0, 0, 0, 0);
                o1 = __builtin_amdgcn_mfma_f32_32x32x16_bf16(VFRAG(l1, h1), pa, o1, 0, 0, 0);
            }
            ATT_SCHED(16, 5);
            if (sub == 1) { A_STORE(sW); ATT_BAR(); }
            else asm volatile("" ::: "memory");
            sc0 = sn0; sc1 = sn1;
        }
        { const int tmp = sV; sV = sK; sK = sW; sW = tmp; }
    }
#undef A_LOAD
#undef A_STORE
    const float inv = 1.0f / pair_sum(l_run);
    constexpr int SP = 272;
    LAS unsigned char* stg = lds + wid * (32 * SP);
#pragma unroll
    for (int db = 0; db < 2; ++db)
#pragma unroll
        for (int g4 = 0; g4 < 4; ++g4) { const f32x16& o = db ? o1 : o0; const int d = 32 * db + 8 * g4 + 4 * hi;
            *(LAS f32x4*)(stg + r32 * SP + d * 4) = (f32x4){o[4 * g4] * inv, o[4 * g4 + 1] * inv, o[4 * g4 + 2] * inv, o[4 * g4 + 3] * inv}; }
    asm volatile("s_waitcnt lgkmcnt(0)" ::: "memory");
    const long wrow0 = seq_row0 + qblk * 256 + wid * 32;
#pragma unroll
    for (int i = 0; i < 4; ++i) {
        const int row = i * 8 + (lane >> 3), ch = lane & 7;
        const f32x4 a = *(const LAS f32x4*)(stg + row * SP + ch * 32), b = *(const LAS f32x4*)(stg + row * SP + ch * 32 + 16);
        const u32x4 gg = *(const u32x4*)(proj + (wrow0 + row) * AB_IN + 768 + head * 64 + ch * 8);
        u32x4 w;
        w.x = cvtpk(a[0] * silu_f(bf_lo(gg.x)), a[1] * silu_f(bf_hi(gg.x))); w.y = cvtpk(a[2] * silu_f(bf_lo(gg.y)), a[3] * silu_f(bf_hi(gg.y)));
        w.z = cvtpk(b[0] * silu_f(bf_lo(gg.z)), b[1] * silu_f(bf_hi(gg.z))); w.w = cvtpk(b[2] * silu_f(bf_lo(gg.w)), b[3] * silu_f(bf_hi(gg.w)));
        *(u32x4*)(O + (wrow0 + row) * DM + head * 64 + ch * 8) = w;
    }
    ATT_BAR();
}

__device__ __forceinline__ void bias_init(f32x16& p0, f32x16& p1, int qloc, int qw0, int kv0, int hi, float nsl, float base) {
    const float fq = (float)(qloc - kv0 - 4 * hi);
    if (kv0 + 63 < qw0 || kv0 > qw0 + 31) {
        const float k = (kv0 + 63 < qw0) ? nsl : -nsl; const float b = k * fq + base;
#pragma unroll
        for (int r = 0; r < 16; ++r) { const float c = (float)((r & 3) + 8 * (r >> 2)); p0[r] = fmaf(-c, k, b); p1[r] = fmaf(-(c + 32.0f), k, b); }
    } else {
#pragma unroll
        for (int r = 0; r < 16; ++r) { const float c = (float)((r & 3) + 8 * (r >> 2)); p0[r] = fmaf(nsl, fabsf(fq - c), base); p1[r] = fmaf(nsl, fabsf(fq - (c + 32.0f)), base); }
    }
}

__device__ __forceinline__ void attn_b_unit(LAS unsigned char* lds, const bf16_t* proj, bf16_t* O, long seq_row0, int S, int hb, int qblk, float lam, const float* subln, float slope2, int t_lo, int t_hi, float mfix, const float* qnw) {
    const int tid = fresh_tid(), lane = tid & 63, r32 = lane & 31, hi = lane >> 5; const int wid = __builtin_amdgcn_readfirstlane(tid >> 6);
    const int map = wid >> 2, wq = wid & 3;
    const int qw0 = qblk * 128 + wq * 32, qloc = qw0 + r32;
    const long qrow = seq_row0 + qloc;
    const bf16_t* Qg = proj + qrow * AB_IN + 1280 + (hb * 2 + map) * 64;

    const int srow = tid >> 3, sch = tid & 7;
    const bf16_t* k1ld = proj + (seq_row0 + srow) * AB_IN + 1792 + hb * 128 + sch * 8;
    const bf16_t* k2ld = k1ld + 64;
    const int vrow0 = tid >> 4, vch = tid & 15;
    const bf16_t* vld = proj + (seq_row0 + vrow0) * AB_IN + 2304 + hb * 128 + vch * 8;
    const unsigned k1st = srow * KP + sch * 16, k2st = 64 * KP + k1st, vst = 2 * 64 * KP + vrow0 * VPB + vch * 16;
    u32x4 k1r, k2r, v0r, v1r;
#define B_LOAD(tt) do { const size_t go = (size_t)(tt) * 64 * AB_IN; k1r = *(const u32x4*)(k1ld + go); k2r = *(const u32x4*)(k2ld + go); v0r = *(const u32x4*)(vld + go); v1r = *(const u32x4*)(vld + go + (size_t)32 * AB_IN); } while (0)
#define B_STORE(off) do { *(LAS u32x4*)(lds + (off) + k1st) = k1r; *(LAS u32x4*)(lds + (off) + k2st) = k2r; *(LAS u32x4*)(lds + (off) + vst) = v0r; *(LAS u32x4*)(lds + (off) + vst + 32 * VPB) = v1r; } while (0)
    B_LOAD(t_lo);
    bf16x8 qr[4];
#pragma unroll
    for (int d0 = 0; d0 < 4; ++d0) qr[d0] = *(const bf16x8*)(Qg + d0 * 16 + hi * 8);
    B_STORE(0);
    B_LOAD(t_lo + 1); B_STORE(BUFB);
    ATT_BAR();
    f32x16 o[4] = {{}, {}, {}, {}}; float l_run = 0.f;
    const unsigned kfo = map * 64 * KP + r32 * KP + hi * 16;
    const unsigned vfo = 2 * 64 * KP + (4 * hi + ((lane & 15) >> 2)) * VPB + (16 * ((lane >> 4) & 1) + 4 * (lane & 3)) * 2;
    const float nsl = -slope2;
    f32x16 sc0, sc1;
    bias_init(sc0, sc1, qloc, qw0, t_lo * 64, hi, nsl, -mfix);
    qk_tile(sc0, sc1, lds + kfo, qr);
    int sV = 0, sK = BUFB, sW = 2 * BUFB;
    for (int t = t_lo; t < t_hi; ++t) {
        B_LOAD(min(t + 2, t_hi - 1));
        f32x16 sn0, sn1;
        bias_init(sn0, sn1, qloc, qw0, (t + 1) * 64, hi, nsl, -mfix);
        qk_tile(sn0, sn1, lds + sK + kfo, qr);
        float ls = 0.f;
#pragma unroll
        for (int r = 0; r < 16; ++r) { sc0[r] = __builtin_amdgcn_exp2f(sc0[r]); ls += sc0[r]; }
#pragma unroll
        for (int r = 0; r < 16; ++r) { sc1[r] = __builtin_amdgcn_exp2f(sc1[r]); ls += sc1[r]; }
        l_run += ls;
#pragma unroll
        for (int ks = 0; ks < 4; ++ks) {
            const bf16x8 pa = (ks < 2) ? pack8(sc0, 8 * ks) : pack8(sc1, 8 * (ks - 2));
            const LAS unsigned char* vb = lds + sV + vfo + ks * 16 * VPB;
#pragma unroll
            for (int db = 0; db < 4; ++db) {
                const s16x4 l0 = vtr(vb + db * 64), h0 = vtr(vb + 8 * VPB + db * 64);
                o[db] = __builtin_amdgcn_mfma_f32_32x32x16_bf16(VFRAG(l0, h0), pa, o[db], 0, 0, 0);
            }
        }
        ATT_SCHED(24, 5);
        B_STORE(sW);
        ATT_BAR();
        sc0 = sn0; sc1 = sn1;
        { const int tmp = sV; sV = sK; sK = sW; sW = tmp; }
    }
#undef B_LOAD
#undef B_STORE
    const float inv = 1.0f / pair_sum(l_run);
    LAS float* comb = (LAS float*)lds + (wq * 32 + r32) * CP;
    if (map == 1) {
#pragma unroll
        for (int db = 0; db < 4; ++db)
#pragma unroll
            for (int g4 = 0; g4 < 4; ++g4) { const int d = 32 * db + 8 * g4 + 4 * hi;
                *(LAS f32x4*)(comb + d) = (f32x4){o[db][4 * g4] * inv, o[db][4 * g4 + 1] * inv, o[db][4 * g4 + 2] * inv, o[db][4 * g4 + 3] * inv}; }
    }
    ATT_BAR();
    if (map == 0) {
        float ss = 0.f;
#pragma unroll
        for (int db = 0; db < 4; ++db)
#pragma unroll
            for (int g4 = 0; g4 < 4; ++g4) { const int d = 32 * db + 8 * g4 + 4 * hi; const f32x4 c = *(const LAS f32x4*)(comb + d);
#pragma unroll
                for (int i = 0; i < 4; ++i) { const float a = o[db][4 * g4 + i] * inv - lam * c[i]; o[db][4 * g4 + i] = a; ss += a * a; } }
        ss = pair_sum(ss);
        const float rstd = __builtin_amdgcn_rsqf(ss * (1.0f / 128.0f) + EPS) * 0.8f;
#pragma unroll
        for (int db = 0; db < 4; ++db)
#pragma unroll
            for (int g4 = 0; g4 < 4; ++g4) { const int d = 32 * db + 8 * g4 + 4 * hi;
                *(LAS f32x4*)(comb + d) = (f32x4){o[db][4 * g4] * rstd, o[db][4 * g4 + 1] * rstd, o[db][4 * g4 + 2] * rstd, o[db][4 * g4 + 3] * rstd}; }
        asm volatile("s_waitcnt lgkmcnt(0)" ::: "memory");
        const long wrow0 = seq_row0 + qblk * 128 + wq * 32;
        const LAS float* wst = (const LAS float*)lds + (wq * 32) * CP;
#pragma unroll
        for (int i = 0; i < 8; ++i) {
            const int row = i * 4 + (lane >> 4), ch = lane & 15;
            const f32x4 a = *(const LAS f32x4*)(wst + row * CP + ch * 8), b = *(const LAS f32x4*)(wst + row * CP + ch * 8 + 4);
            const u32x4 gg = *(const u32x4*)(proj + (wrow0 + row) * AB_IN + 2816 + hb * 128 + ch * 8);
            const f32x4 s0 = *(const f32x4*)(subln + ch * 8), s1 = *(const f32x4*)(subln + ch * 8 + 4);
            u32x4 w;
            w.x = cvtpk(a[0] * s0[0] * silu_f(bf_lo(gg.x)), a[1] * s0[1] * silu_f(bf_hi(gg.x))); w.y = cvtpk(a[2] * s0[2] * silu_f(bf_lo(gg.y)), a[3] * s0[3] * silu_f(bf_hi(gg.y)));
            w.z = cvtpk(b[0] * s1[0] * silu_f(bf_lo(gg.z)), b[1] * s1[1] * silu_f(bf_hi(gg.z))); w.w = cvtpk(b[2] * s1[2] * silu_f(bf_lo(gg.w)), b[3] * s1[3] * silu_f(bf_hi(gg.w)));
            *(u32x4*)(O + (wrow0 + row) * DM + 512 + hb * 128 + ch * 8) = w;
        }
    }
    ATT_BAR();
}
}

__device__ __forceinline__ float wave_sum(float v) {
#pragma unroll
    for (int o = 1; o < 64; o <<= 1) v += __shfl_xor(v, o);
    return v;
}
__device__ __forceinline__ void p0_transpose_item(const float* W, int K, int N, const float* gain, bf16_t* WT, int row_off, LAS float* scr, int item, int lane, bool kperm = false) {
    const int nblk = N / 32, kb = item / nblk, nb = item % nblk, k0 = 64 * kb, n0 = 32 * nb;
    int n0d = n0;
    if (kperm) { const int pn = n0 >> 8, c = n0 & 255; if (pn <= 2 || (pn >= 5 && pn <= 8)) n0d = (n0 & ~255) + 128 * ((c >> 5) & 1) + 32 * (c >> 6); }
#pragma unroll 8
    for (int i = 0; i < 32; ++i) { const int kk = 2 * i + (lane >> 5); float v = W[(size_t)(k0 + kk) * N + n0 + (lane & 31)]; if (gain) v *= gain[k0 + kk]; scr[kk * 33 + (lane & 31)] = v; }
    asm volatile("s_waitcnt lgkmcnt(0)" ::: "memory");
    const int c = lane & 7;
#pragma unroll
    for (int j = 0; j < 4; ++j) { const int n = (lane >> 3) + 8 * j; const LAS float* s = scr + (8 * c) * 33 + n;
        u32x4 o; o.x = cvtpk(s[0 * 33], s[1 * 33]); o.y = cvtpk(s[2 * 33], s[3 * 33]); o.z = cvtpk(s[4 * 33], s[5 * 33]); o.w = cvtpk(s[6 * 33], s[7 * 33]);
        *(u32x4*)(WT + (size_t)(row_off + n0d + n) * K + k0 + 8 * c) = o; }
    asm volatile("s_waitcnt lgkmcnt(0)" ::: "memory");
}


template <int W2, int R> __device__ __forceinline__ void pool_run(const bf16_t* ug, bf16_t* pool, int sb, int S, int t0, int col) {
    constexpr int NR = R + 2 * W2;
    u32x4 r[NR];
#pragma unroll
    for (int i = 0; i < NR; ++i) { const int t = t0 - W2 + i; const bool ok = (t >= 0) && (t < S); const int tc = ok ? t : t0;
        const u32x4 v = *(const u32x4*)(ug + (size_t)(sb + tc) * 2048 + col); r[i] = ok ? v : (u32x4){0u, 0u, 0u, 0u}; }
    float s[8];
#pragma unroll
    for (int c = 0; c < 8; ++c) s[c] = 0.f;
#pragma unroll
    for (int i = 0; i < 2 * W2; ++i) { s[0] += bf_lo(r[i].x); s[1] += bf_hi(r[i].x); s[2] += bf_lo(r[i].y); s[3] += bf_hi(r[i].y); s[4] += bf_lo(r[i].z); s[5] += bf_hi(r[i].z); s[6] += bf_lo(r[i].w); s[7] += bf_hi(r[i].w); }
#pragma unroll
    for (int k = 0; k < R; ++k) {
        const int t = t0 + k; const int cnt = min(t + W2, S) - max(t - W2, 0); const float ic = 1.0f / (float)cnt;
        const u32x4 c = r[k + W2];
        u32x4 w;
        w.x = cvtpk(s[0] * ic - bf_lo(c.x), s[1] * ic - bf_hi(c.x)); w.y = cvtpk(s[2] * ic - bf_lo(c.y), s[3] * ic - bf_hi(c.y));
        w.z = cvtpk(s[4] * ic - bf_lo(c.z), s[5] * ic - bf_hi(c.z)); w.w = cvtpk(s[6] * ic - bf_lo(c.w), s[7] * ic - bf_hi(c.w));
        *(u32x4*)(pool + (size_t)(sb + t) * DM + col) = w;
        if (k < R - 1) { const u32x4 a = r[k + 2 * W2], b = r[k];
            s[0] += bf_lo(a.x) - bf_lo(b.x); s[1] += bf_hi(a.x) - bf_hi(b.x); s[2] += bf_lo(a.y) - bf_lo(b.y); s[3] += bf_hi(a.y) - bf_hi(b.y);
            s[4] += bf_lo(a.z) - bf_lo(b.z); s[5] += bf_hi(a.z) - bf_hi(b.z); s[6] += bf_lo(a.w) - bf_lo(b.w); s[7] += bf_hi(a.w) - bf_hi(b.w); }
    }
}


#define XB_TMO      128
#define XB_XCNT(j)  (256  + 64 * (j))
#define XB_XSUB(j)  (1280 + 64 * (j))
#define XB_XGEN(j)  (2304 + 64 * (j))
#define XB_TOP      3328
#define XB_TOPGEN   3392
#define XCD_BAR_WORDS 3456
#define XB_SPIN_CAP (1u << 18)
__device__ __forceinline__ unsigned xb_ld(unsigned* p)              { return __hip_atomic_load(p, __ATOMIC_RELAXED, __HIP_MEMORY_SCOPE_AGENT); }
__device__ __forceinline__ unsigned xb_add(unsigned* p, unsigned v) { return __hip_atomic_fetch_add(p, v, __ATOMIC_RELAXED, __HIP_MEMORY_SCOPE_AGENT); }
__device__ __forceinline__ unsigned xb_xcc_id() { return (unsigned)__builtin_amdgcn_s_getreg((3 << 11) | 20) & 0xFu; }
#define XB_SPIN(cond, bar) do { unsigned _sp = 0; while (cond) { __builtin_amdgcn_s_sleep(1); \
    if ((++_sp & 255u) == 0u) { if (xb_ld(&(bar)[XB_TMO])) break; if (_sp > XB_SPIN_CAP) { atomicAdd(&(bar)[XB_TMO], 1u); break; } } } } while (0)
struct XcdBarrier { unsigned* bar; unsigned x; volatile LAS unsigned* st; };
__device__ __forceinline__ XcdBarrier xcd_barrier_post(unsigned* bar, volatile LAS unsigned* st) {
    XcdBarrier b; b.bar = bar; b.x = xb_xcc_id(); b.st = st;
    if (threadIdx.x == 0) (void)xb_add(&bar[XB_XCNT(b.x)], 1u);
    return b;
}
__device__ __forceinline__ void xcd_barrier_complete(unsigned* bar, unsigned x, unsigned& nloc, unsigned& nx) {
    const unsigned G = gridDim.x * gridDim.y * gridDim.z;
    unsigned sum, cnt, mine, sp = 0u;
    for (;;) {
        sum = 0u; cnt = 0u; mine = 0u;
#pragma unroll
        for (unsigned j = 0; j < 16; ++j) { const unsigned c = xb_ld(&bar[XB_XCNT(j)]); sum += c; cnt += (c > 0u) ? 1u : 0u; mine = (j == x) ? c : mine; }
        if (sum == G) break;
        __builtin_amdgcn_s_sleep(1);
        if ((++sp & 255u) == 0u) { if (xb_ld(&bar[XB_TMO])) break; if (sp > XB_SPIN_CAP) { atomicAdd(&bar[XB_TMO], 1u); break; } }
    }
    nloc = mine > 0u ? mine : 1u; nx = cnt > 0u ? cnt : 1u;
}
__device__ __forceinline__ void xcd_barrier(const XcdBarrier& b) {
    asm volatile("s_waitcnt vmcnt(0)" ::: "memory");
    __syncthreads();
    if (threadIdx.x == 0) {
        unsigned* bar = b.bar;
        __builtin_amdgcn_s_waitcnt(0);
        unsigned nloc = b.st[0], nx = b.st[1];
        if (nloc == 0u) { xcd_barrier_complete(bar, b.x, nloc, nx); b.st[0] = nloc; b.st[1] = nx; }
        const unsigned old = xb_add(&bar[XB_XSUB(b.x)], 1u);
        const unsigned gen = old / nloc;
        if (old + 1u == (gen + 1u) * nloc) {
            __builtin_amdgcn_fence(__ATOMIC_RELEASE, "agent");
            asm volatile("s_waitcnt vmcnt(0)" ::: "memory");
            const unsigned og = xb_add(&bar[XB_TOP], 1u);
            const unsigned tg = og / nx;
            if (og + 1u == (tg + 1u) * nx) xb_add(&bar[XB_TOPGEN], 1u);
            else XB_SPIN(xb_ld(&bar[XB_TOPGEN]) == tg, bar);
            __builtin_amdgcn_fence(__ATOMIC_ACQUIRE, "agent");
            xb_add(&bar[XB_XGEN(b.x)], 1u);
            asm volatile("s_waitcnt vmcnt(0)" ::: "memory");
        } else {
            XB_SPIN(xb_ld(&bar[XB_XGEN(b.x)]) == gen, bar);
            __builtin_amdgcn_fence(__ATOMIC_ACQUIRE, "agent");
            asm volatile("s_waitcnt vmcnt(0)" ::: "memory");
        }
    }
    __syncthreads();
}

struct Args { const float* in[23]; float* out; unsigned char* ws; int ph_lo, ph_hi; };

__global__ void __launch_bounds__(512, 2) mega_fwd(Args args) {
    extern __shared__ __attribute__((aligned(16))) unsigned char lds_raw[];
    LAS unsigned char* lds = (LAS unsigned char*)lds_raw;
    const int G = gridDim.x, bx = blockIdx.x;
#define FRESH_IDS const int tid = fresh_tid(), lane = tid & 63; const int wave = __builtin_amdgcn_readfirstlane(tid >> 6); (void)lane; (void)wave
    unsigned char* ws = args.ws;
    const int lo = args.ph_lo, hi = args.ph_hi;
#define IN(k) (lo <= (k) && (k) < hi)
#define SEAM(k) do { if (IN(k) && IN((k) + 1)) { xcd_barrier(xbar); } } while (0)
    volatile LAS unsigned* xst = (volatile LAS unsigned*)(lds + att::CTL_OFF + 64);
    if (threadIdx.x < 2) xst[threadIdx.x] = 0u;
    __syncthreads();
    XcdBarrier xbar; xbar.bar = (unsigned*)(ws + WS_BAR); xbar.x = 0; xbar.st = xst;
    xbar = xcd_barrier_post((unsigned*)(ws + WS_BAR), xst);
    if (hi > 1000) cg::this_grid().sync();
    const float* x_prompt = args.in[0]; const float* x_sample = args.in[1];
    bf16_t* proj = (bf16_t*)(ws + WS_PROJ); bf16_t* XN = (bf16_t*)(ws + WS_XN);
    float* outp = args.out;

    if (IN(0)) {
        FRESH_IDS;
        LAS float* scr = (LAS float*)(lds + wave * 16384);
        const int gw = bx * 8 + wave, NGW = G * 8;
        constexpr int I0 = 16 * 104, I1 = 512, I2 = 512, I3 = 512, I4 = 128, I5 = 128, I6 = 1024, I7 = 128, I8 = 512;
        constexpr int NITEMS = I0 + I1 + I2 + I3 + I4 + I5 + I6 + I7 + I8;
        for (int it = gw; it < NITEMS; it += NGW) {
            int r = it;
            if (r < I0) { p0_transpose_item(args.in[5], 1024, 3328, nullptr, (bf16_t*)(ws + WS_WIN), 0, scr, r, lane, true); continue; } r -= I0;
            if (r < I1) { p0_transpose_item(args.in[15], 1024, 1024, nullptr, (bf16_t*)(ws + WS_WO), 0, scr, r, lane); continue; } r -= I1;
            if (r < I2) { p0_transpose_item(args.in[21], 1024, 1024, args.in[20], (bf16_t*)(ws + WS_WG0), 0, scr, r, lane); continue; } r -= I2;
            if (r < I3) { p0_transpose_item(args.in[21] + 1024 * 1024, 1024, 1024, args.in[20] + 1024, (bf16_t*)(ws + WS_WG1), 0, scr, r, lane); continue; } r -= I3;
            if (r < I4) { p0_transpose_item(args.in[22], 256, 1024, nullptr, (bf16_t*)(ws + WS_WP0), 0, scr, r, lane); continue; } r -= I4;
            if (r < I5) { p0_transpose_item(args.in[22] + 256 * 1024, 256, 1024, nullptr, (bf16_t*)(ws + WS_WP1), 0, scr, r, lane); continue; } r -= I5;
            if (r < I6) { p0_transpose_item(args.in[16], 1024, 2048, args.in[4] + 1024, (bf16_t*)(ws + WS_WIC), 0, scr, r, lane); continue; } r -= I6;
            if (r < I7) { const int gi = r / 32; p0_transpose_item(args.in[17] + (size_t)gi * 65536, 256, 256, nullptr, (bf16_t*)(ws + WS_WGRP), gi * 256, scr, r % 32, lane); continue; } r -= I7;
            p0_transpose_item(args.in[19], 1024, 1024, nullptr, (bf16_t*)(ws + WS_WOC), 0, scr, r, lane);
        }
        if (bx == 0) { if (tid < 256) ((float*)(ws + WS_CTL + 4096))[tid] = args.in[6 + (tid >> 6)][tid & 63];
                       if (tid == 0) *(unsigned*)(ws + WS_CTL) = 0u; }
        const float* g0 = args.in[4];
        for (int m0 = gw * 2; m0 < MTOT; m0 += NGW * 2) {
            f32x4 v[2][4];
#pragma unroll
            for (int tk = 0; tk < 2; ++tk) { const int m = m0 + tk; const float* xr = (m < M_PROMPT) ? x_prompt + (size_t)m * DM : x_sample + (size_t)(m - M_PROMPT) * DM;
#pragma unroll
                for (int j = 0; j < 4; ++j) v[tk][j] = __builtin_nontemporal_load((const f32x4*)xr + lane + 64 * j); }
#pragma unroll
            for (int tk = 0; tk < 2; ++tk) { float s2 = 0.f;
#pragma unroll
                for (int j = 0; j < 4; ++j) s2 += (v[tk][j][0] * v[tk][j][0] + v[tk][j][1] * v[tk][j][1]) + (v[tk][j][2] * v[tk][j][2] + v[tk][j][3] * v[tk][j][3]);
                const float rstd = __builtin_amdgcn_rsqf(wave_sum(s2) * (1.0f / DM) + EPS);
                u32x2* o8 = (u32x2*)(XN + (size_t)(m0 + tk) * DM) + lane;
#pragma unroll
                for (int j = 0; j < 4; ++j) { const f32x4 gg = ((const f32x4*)g0)[lane + 64 * j]; u32x2 w;
                    w.x = cvtpk(v[tk][j][0] * rstd * gg[0], v[tk][j][1] * rstd * gg[1]); w.y = cvtpk(v[tk][j][2] * rstd * gg[2], v[tk][j][3] * rstd * gg[3]); o8[64 * j] = w; } }
        }
        const size_t gt = (size_t)bx * 512 + tid, NT = (size_t)G * 512;
#pragma unroll 1
        for (int l = 0; l < 2; ++l) {
            const float* pp = args.in[2] + (size_t)l * M_PROMPT * PLE; const float* ps = args.in[3] + (size_t)l * M_SAMPLE * PLE;
            bf16_t* pb = (bf16_t*)(ws + (l ? WS_PB1 : WS_PB0));
            constexpr size_t NP8 = (size_t)M_PROMPT * PLE / 8, NA8 = (size_t)MTOT * PLE / 8;
            for (size_t i0 = gt; i0 < NA8; i0 += 4 * NT) {
                f32x4 a[4], b[4];
#pragma unroll
                for (int q = 0; q < 4; ++q) { const size_t i = i0 + (size_t)q * NT; if (i < NA8) { const float* src = (i < NP8) ? pp + i * 8 : ps + (i - NP8) * 8; a[q] = __builtin_nontemporal_load((const f32x4*)src); b[q] = __builtin_nontemporal_load((const f32x4*)src + 1); } }
#pragma unroll
                for (int q = 0; q < 4; ++q) { const size_t i = i0 + (size_t)q * NT; if (i < NA8) { u32x4 w; w.x = cvtpk(a[q][0], a[q][1]); w.y = cvtpk(a[q][2], a[q][3]); w.z = cvtpk(b[q][0], b[q][1]); w.w = cvtpk(b[q][2], b[q][3]);
                    __builtin_nontemporal_store(w, (u32x4*)(pb + i * 8)); } }
            }
        }
    }
    SEAM(0);

    if (IN(1)) {
        pg8::Gemm g{XN, (const bf16_t*)(ws + WS_WIN), DM, DM, DM, 0, MTOT, AB_IN}; pg8::StaticOrder S; S.init(MTOT, AB_IN, G, bx);
        pg8::EpiProj E{proj, (const float*)(ws + WS_CTL + 4096)};
        pg8::gemm_phase<pg8::EpiProj>(lds, g, S, E);
    }
    SEAM(1);


    if (IN(3)) {
        FRESH_IDS;
        LAS float* ctlf = (LAS float*)(lds + att::CTL_OFF); LAS unsigned* ctlu = (LAS unsigned*)(lds + att::CTL_OFF);
        if (wave == 0) {
            const float a = args.in[10][lane] * args.in[11][lane], b = args.in[12][lane] * args.in[13][lane];
            const float sa = wave_sum(a), sb = wave_sum(b);
            float gq = fabsf(args.in[8][lane]), gk = fabsf(args.in[9][lane]), aq = fabsf(args.in[6][lane]), ak = fabsf(args.in[7][lane]);
#pragma unroll
            for (int o = 1; o < 64; o <<= 1) { gq = fmaxf(gq, __shfl_xor(gq, o)); gk = fmaxf(gk, __shfl_xor(gk, o)); aq = fmaxf(aq, __shfl_xor(aq, o)); ak = fmaxf(ak, __shfl_xor(ak, o)); }
            if (lane == 0) { ctlf[1] = __expf(sa) - __expf(sb) + 0.2f;
                ctlf[3] = 8.0f * gq * gk * LOG2E * 1.02f;
                ctlf[4] = 8.0f * aq * ak * LOG2E * 1.02f;
                ctlf[2] = 2.0f * (8.0f * gq * gk * LOG2E * 1.02f) + 80.0f; }
        }
        __syncthreads();
        const float lam = __uint_as_float(__builtin_amdgcn_readfirstlane(__float_as_uint(ctlf[1]))), margin2 = __uint_as_float(__builtin_amdgcn_readfirstlane(__float_as_uint(ctlf[2])));
        const float mfixB = __uint_as_float(__builtin_amdgcn_readfirstlane(__float_as_uint(ctlf[3]))), mfixA = __uint_as_float(__builtin_amdgcn_readfirstlane(__float_as_uint(ctlf[4])));
        const float* subln = args.in[14];
        bf16_t* O = XN;
        unsigned* qctr = (unsigned*)(ws + WS_CTL);
        constexpr int NU = 256 + 1024 + 3 * 256 + 2048 + 2048;
        if (threadIdx.x == 0) ctlu[0] = atomicAdd(qctr, 1u);
        __syncthreads();
        int u_next = (int)__builtin_amdgcn_readfirstlane(ctlu[0]);
        __syncthreads();
        for (;;) {
            int u = u_next;
            if (u >= NU) break;
            unsigned nxt = 0u;
            if (threadIdx.x == 0) nxt = atomicAdd(qctr, 1u);
            int kind, hd, qb, seq, S; long row0;
            if (u < 256) { kind = 1; hd = 3; qb = u & 127; seq = u >> 7; S = S_PROMPT; row0 = (long)seq * S_PROMPT; }
            else if (u < 1280) { u -= 256; kind = 0; qb = u & 63; hd = (u >> 6) & 7; seq = u >> 9; S = S_PROMPT; row0 = (long)seq * S_PROMPT; }
            else if (u < 2048) { u -= 1280; kind = 1; hd = 2 - (u >> 8); u &= 255; qb = u & 127; seq = u >> 7; S = S_PROMPT; row0 = (long)seq * S_PROMPT; }
            else if (u < 4096) { u -= 2048; kind = 1; qb = u & 15; hd = 3 - ((u >> 4) & 3); seq = u >> 6; S = S_SAMPLE; row0 = (long)M_PROMPT + (long)seq * S_SAMPLE; }
            else { u -= 4096; kind = 0; qb = u & 7; hd = (u >> 3) & 7; seq = u >> 6; S = S_SAMPLE; row0 = (long)M_PROMPT + (long)seq * S_SAMPLE; }
            if (kind == 1) {
                const float slope2 = exp2f(-2.0f * (float)(hd + 1)) * LOG2E;
                const int D = (int)ceilf(margin2 / slope2);
                const int q0 = qb * 128, NT = S / 64;
                int t_lo = (q0 - 63 - D >= 0) ? ((q0 - 63 - D) / 64 + 1) : 0;
                int t_hi = (q0 + 127 + D) / 64 + 1; if (t_hi > NT) t_hi = NT;
                att::attn_b_unit(lds, proj, O, row0, S, hd, qb, lam, subln, slope2, t_lo, t_hi, mfixB, args.in[8]);
            } else {
                att::attn_a_unit(lds, proj, O, row0, S, hd, qb, mfixA, args.in[6]);
            }
            if (threadIdx.x == 0) ctlu[0] = nxt;
            __syncthreads();
            u_next = (int)__builtin_amdgcn_readfirstlane(ctlu[0]);
            __syncthreads();
        }
    }
    SEAM(3);

    if (IN(4)) {
        pg8::Gemm g{XN, (const bf16_t*)(ws + WS_WO), DM, DM, DM, 0, MTOT, DM}; pg8::StaticOrder S; S.init(MTOT, DM, G, bx);
        pg8::EpiResid<false> E{x_prompt, x_sample, M_PROMPT, nullptr, (bf16_t*)(ws + WS_H1B), (float*)(ws + WS_SS1)};
        pg8::gemm_phase<pg8::EpiResid<false>>(lds, g, S, E);
    }
    SEAM(4);

    if (IN(5)) {
        { pg8::Gemm g{(const bf16_t*)(ws + WS_PB0), (const bf16_t*)(ws + WS_WP0), PLE, PLE, PLE, 0, MTOT, DM}; pg8::StaticOrder S; S.init(MTOT, DM, G, bx);
          pg8::EpiBf16S E{(bf16_t*)(ws + WS_PP), DM, nullptr};
          pg8::gemm_phase<pg8::EpiBf16S>(lds, g, S, E); }
        { pg8::Gemm g{(const bf16_t*)(ws + WS_H1B), (const bf16_t*)(ws + WS_WG0), DM, DM, DM, 0, MTOT, DM}; pg8::StaticOrder S; S.init(MTOT, DM, G, bx);
          pg8::EpiGate E{(const bf16_t*)(ws + WS_H1B), (const bf16_t*)(ws + WS_PP), (const float*)(ws + WS_SS1), XN, (float*)(ws + WS_SS2), nullptr};
          pg8::gemm_phase<pg8::EpiGate>(lds, g, S, E); }
    }
    SEAM(5);

    if (IN(6)) {
        pg8::Gemm g{XN, (const bf16_t*)(ws + WS_WIC), DM, DM, DM, 0, MTOT, 2048}; pg8::StaticOrder S; S.init(MTOT, 2048, G, bx);
        pg8::EpiBf16S E{(bf16_t*)(ws + WS_UG), 2048, (const float*)(ws + WS_SS2)};
        pg8::gemm_phase<pg8::EpiBf16S>(lds, g, S, E);
    }
    SEAM(6);

    if (IN(7)) {
        FRESH_IDS;
        const bf16_t* ug = (const bf16_t*)(ws + WS_UG); bf16_t* pool = (bf16_t*)(ws + WS_POOL);
        pg8::StaticOrder SP; SP.init(MTOT, DM, G, bx);
        pg8::Unit pu;
        for (int i = 0; SP.next(i, pu); ++i) {
            const int gi = pu.pn, run = pu.pm * 16 + wave * 2 + (lane >> 5), col = gi * 256 + (lane & 31) * 8;
            const int m0 = run * 16;
            int sb, S;
            if (m0 < M_PROMPT) { sb = m0 & ~(S_PROMPT - 1); S = S_PROMPT; } else { sb = M_PROMPT + ((m0 - M_PROMPT) & ~(S_SAMPLE - 1)); S = S_SAMPLE; }
            const int t0 = m0 - sb;
            switch (gi) {
                case 0: pool_run<1, 16>(ug, pool, sb, S, t0, col); break;
                case 1: pool_run<2, 16>(ug, pool, sb, S, t0, col); break;
                case 2: pool_run<4, 8>(ug, pool, sb, S, t0, col); asm volatile("" ::: "memory"); pool_run<4, 8>(ug, pool, sb, S, t0 + 8, col); break;
                default: pool_run<8, 8>(ug, pool, sb, S, t0, col); asm volatile("" ::: "memory"); pool_run<8, 8>(ug, pool, sb, S, t0 + 8, col); break;
            }
        }
    }
    if (IN(7) && IN(8)) { asm volatile("s_waitcnt vmcnt(0)" ::: "memory"); __syncthreads(); }

    if (IN(8)) {
        pg8::Gemm g{(const bf16_t*)(ws + WS_POOL), (const bf16_t*)(ws + WS_WGRP), DM, 256, 256, 256, MTOT, DM}; pg8::StaticOrder S; S.init(MTOT, DM, G, bx);
        pg8::EpiGrp E{(bf16_t*)outp, (const bf16_t*)(ws + WS_UG), args.in[18]};
        pg8::gemm_phase<pg8::EpiGrp>(lds, g, S, E);
    }
    SEAM(8);

    if (IN(9)) {
        pg8::Gemm g{(const bf16_t*)outp, (const bf16_t*)(ws + WS_WOC), DM, DM, DM, 0, MTOT, DM}; pg8::StaticOrder S; S.init(MTOT, DM, G, bx);
        pg8::EpiResid<true> E{nullptr, nullptr, 0, XN, (bf16_t*)(ws + WS_H3B), (float*)(ws + WS_SS3)};
        pg8::gemm_phase<pg8::EpiResid<true>>(lds, g, S, E);
    }
    SEAM(9);

    if (IN(10)) {
        { pg8::Gemm g{(const bf16_t*)(ws + WS_PB1), (const bf16_t*)(ws + WS_WP1), PLE, PLE, PLE, 0, MTOT, DM}; pg8::StaticOrder S; S.init(MTOT, DM, G, bx);
          pg8::EpiBf16S E{(bf16_t*)(ws + WS_PP1), DM, nullptr};
          pg8::gemm_phase<pg8::EpiBf16S>(lds, g, S, E); }
        { pg8::Gemm g{(const bf16_t*)(ws + WS_H3B), (const bf16_t*)(ws + WS_WG1), DM, DM, DM, 0, MTOT, DM}; pg8::StaticOrder S; S.init(MTOT, DM, G, bx);
          pg8::EpiGate E{(const bf16_t*)(ws + WS_H3B), (const bf16_t*)(ws + WS_PP1), (const float*)(ws + WS_SS3), nullptr, nullptr, outp};
          pg8::gemm_phase<pg8::EpiGate>(lds, g, S, E); }
    }
#undef IN
#undef SEAM
}

constexpr int LDS_BYTES = 147456;
constexpr int N_PHASES = 11;

extern "C" void kernel_launch(void* const* d_in, const int* in_sizes, int n_in, void* d_out, int out_size, void* d_ws, size_t ws_size, hipStream_t stream) {
    static int grid = 0;
    if (grid == 0) {
        if (n_in != 23 || out_size != MTOT * DM || ws_size < WS_END) { fprintf(stderr, "kernel_launch: unexpected shapes (n_in %d out %d ws %zu)\n", n_in, out_size, ws_size); grid = -1; return; }
        int dev = 0, cus = 0, per_cu = 0;
        hipGetDevice(&dev);
        hipDeviceGetAttribute(&cus, hipDeviceAttributeMultiprocessorCount, dev);
        hipFuncSetAttribute((const void*)mega_fwd, hipFuncAttributeMaxDynamicSharedMemorySize, LDS_BYTES);
        hipOccupancyMaxActiveBlocksPerMultiprocessor(&per_cu, (const void*)mega_fwd, 512, LDS_BYTES);
        if (per_cu < 1) { fprintf(stderr, "kernel_launch: occupancy query says %d blocks per CU\n", per_cu); per_cu = 1; }
        (void)hipGetLastError();
        grid = cus * 1;
    }
    if (grid < 0) return;
    Args a{};
    for (int i = 0; i < 23; ++i) a.in[i] = (const float*)d_in[i];
    a.out = (float*)d_out; a.ws = (unsigned char*)d_ws;
#if MK_ONE_LAUNCH
#ifdef PROBE_LO
    for (int li = 0; li < 2; ++li) {
        a.ph_lo = li ? PROBE_LO : 0; a.ph_hi = li ? N_PHASES : PROBE_HI;
        if (li) { hipMemsetAsync((char*)d_ws + WS_CTL, 0, 4, stream); hipMemsetAsync((char*)d_ws + WS_BAR, 0, XCD_BAR_WORDS * 4, stream); }
        void* kargs[] = {&a};
        hipError_t e = hipLaunchCooperativeKernel((const void*)mega_fwd, dim3(grid), dim3(512), kargs, LDS_BYTES, stream);
        if (e != hipSuccess) fprintf(stderr, "cooperative launch failed: %s (grid %d)\n", hipGetErrorString(e), grid);
    }
#else
    a.ph_lo = 0; a.ph_hi = N_PHASES;
    (void)hipMemsetAsync((char*)d_ws + WS_BAR, 0, XCD_BAR_WORDS * 4, stream);
    void* kargs[] = {&a};
    hipError_t e = hipLaunchCooperativeKernel((const void*)mega_fwd, dim3(grid), dim3(512), kargs, LDS_BYTES, stream);
    if (e != hipSuccess) fprintf(stderr, "cooperative launch failed: %s (grid %d)\n", hipGetErrorString(e), grid);
#endif
#else
    for (int p = 0; p < N_PHASES; ++p) { a.ph_lo = p; a.ph_hi = p + 1; hipLaunchKernelGGL(mega_fwd, dim3(grid), dim3(512), LDS_BYTES, stream, a); }
#endif
}
```
